# Optimizing an MI355X kernel written in HIP

```python
import math
import jax, jax.numpy as jnp
from jax import lax
import numpy as np

D_MODEL = 2048
BATCH = 1
SEQ = 8192
DEPTH = 4

HEAD_DIM = 128
N_HEADS_TOTAL = D_MODEL // HEAD_DIM
N_HEADS_C = N_HEADS_TOTAL // 4
N_HEADS_A = (N_HEADS_TOTAL - N_HEADS_C) // 2
N_HEADS_B = N_HEADS_TOTAL - N_HEADS_C - N_HEADS_A
DIFF_QK_DIM = HEAD_DIM // 2
WIDTH_A = N_HEADS_A * HEAD_DIM
WIDTH_B = N_HEADS_B * HEAD_DIM
WIDTH_C = N_HEADS_C * HEAD_DIM
MIX_WIDTH = WIDTH_A + WIDTH_B + WIDTH_C
IN_COLS = 3 * WIDTH_A + 3 * WIDTH_B + 2 * WIDTH_C
DILATION_PATTERNS = ((128, 1), (512, 4), (2048, 16))
BLK = 128
CHUNK = 128
ROPE_THETA = 500000.0
ROPE_FRACTION = 4
FFN_DIM = 5632
CONV_WIDTH = 3
EPS = 1e-6

kernel_name = "hybrid_dilated_diff_sgu_convffn"


def rmsnorm(x, g):
    xf = x.astype(jnp.float32)
    y = xf * lax.rsqrt(jnp.mean(xf * xf, axis=-1, keepdims=True) + EPS)
    return (y * g.astype(jnp.float32)).astype(x.dtype)


def layernorm(x, g, b):
    xf = x.astype(jnp.float32)
    mu = jnp.mean(xf, axis=-1, keepdims=True)
    var = jnp.mean(jnp.square(xf - mu), axis=-1, keepdims=True)
    y = (xf - mu) * lax.rsqrt(var + EPS)
    return (y * g.astype(jnp.float32) + b.astype(jnp.float32)).astype(x.dtype)


def rope_tables(seq, head_dim):
    rot_dim = head_dim // ROPE_FRACTION
    inv = 1.0 / (ROPE_THETA ** (jnp.arange(0, rot_dim, 2, dtype=jnp.float32) / rot_dim))
    ang = jnp.arange(seq, dtype=jnp.float32)[:, None] * inv[None, :]
    return jnp.cos(ang), jnp.sin(ang)


def rope_partial(x, cos, sin):
    rd = cos.shape[-1] * 2
    xr = x[..., :rd].astype(jnp.float32)
    x1, x2 = xr[..., : rd // 2], xr[..., rd // 2:]
    c = cos[None, :, None, :]
    s = sin[None, :, None, :]
    rot = jnp.concatenate([x1 * c - x2 * s, x2 * c + x1 * s], axis=-1)
    return jnp.concatenate([rot.astype(x.dtype), x[..., rd:]], axis=-1)


def banded_window_attn(q, k, v, window):
    N, L, H, dh = q.shape
    nb = L // BLK
    scale = dh ** -0.5
    qb = q.reshape(N, nb, BLK, H, dh)
    kb = k.reshape(N, nb, BLK, H, dh)
    vb = v.reshape(N, nb, BLK, H, dh)
    pad = ((0, 0), (1, 0), (0, 0), (0, 0), (0, 0))
    kcat = jnp.concatenate([jnp.pad(kb, pad)[:, :-1], kb], axis=2)
    vcat = jnp.concatenate([jnp.pad(vb, pad)[:, :-1], vb], axis=2)
    s = jnp.einsum('nbqhd,nbkhd->nbhqk', qb, kcat, preferred_element_type=jnp.float32) * scale
    qi = jnp.arange(BLK)[:, None] + BLK
    kj = jnp.arange(2 * BLK)[None, :]
    dist = qi - kj
    band = (dist >= 0) & (dist <= window)
    has_prev = (jnp.arange(nb) > 0)[:, None, None] | (kj >= BLK)[None]
    mask = band[None] & has_prev
    s = jnp.where(mask[None, :, None], s, -jnp.inf)
    m = jnp.max(s, axis=-1, keepdims=True)
    p = jnp.exp(s - m)
    l = jnp.sum(p, axis=-1)
    o = jnp.einsum('nbhqk,nbkhd->nbqhd', p.astype(v.dtype), vcat, preferred_element_type=jnp.float32)
    o = o / jnp.transpose(l, (0, 1, 3, 2))[..., None]
    lse = jnp.transpose(m[..., 0] + jnp.log(l), (0, 1, 3, 2))
    return o.reshape(N, L, H, dh), lse.reshape(N, L, H)


def dilated_window_attn(q, k, v, window, dilation):
    B, S, H, dh = q.shape
    span = dilation * BLK
    Sp = -(-S // span) * span
    Ls = Sp // dilation

    def to_sub(t):
        t = jnp.pad(t, ((0, 0), (0, Sp - S), (0, 0), (0, 0)))
        return t.reshape(B, Ls, dilation, H, dh).transpose(0, 2, 1, 3, 4).reshape(B * dilation, Ls, H, dh)

    o, lse = banded_window_attn(to_sub(q), to_sub(k), to_sub(v), window // dilation)
    o = o.reshape(B, dilation, Ls, H, dh).transpose(0, 2, 1, 3, 4).reshape(B, Sp, H, dh)[:, :S]
    lse = lse.reshape(B, dilation, Ls, H).transpose(0, 2, 1, 3).reshape(B, Sp, H)[:, :S]
    return o, lse


def dilated_mixture(q, k, v):
    outs, lses = [], []
    for window, dilation in DILATION_PATTERNS:
        o, lse = dilated_window_attn(q, k, v, window, dilation)
        outs.append(o)
        lses.append(lse)
    w = jax.nn.softmax(jnp.stack(lses, axis=0), axis=0)
    o = jnp.sum(w[..., None] * jnp.stack(outs, axis=0), axis=0)
    return o.astype(q.dtype)


def diff_attention(q1, q2, k1, k2, v, lam):
    B, S, H, dq = q1.shape
    dv = v.shape[-1]
    nq = S // BLK
    scale = dq ** -0.5
    kpos = jnp.arange(S)

    def split(t):
        return t.reshape(B, nq, BLK, H, t.shape[-1]).transpose(1, 0, 2, 3, 4)

    def step(args):
        qa, qb, bi = args
        qpos = bi * BLK + jnp.arange(BLK)
        mask = qpos[:, None] >= kpos[None, :]

        def probs(qq, kk):
            s = jnp.einsum('bqhd,bkhd->bhqk', qq, kk, preferred_element_type=jnp.float32) * scale
            return jax.nn.softmax(jnp.where(mask, s, -jnp.inf), axis=-1)

        p = probs(qa, k1) - lam * probs(qb, k2)
        return jnp.einsum('bhqk,bkhd->bqhd', p.astype(v.dtype), v, preferred_element_type=jnp.float32).astype(v.dtype)

    out = lax.map(step, (split(q1), split(q2), jnp.arange(nq)))
    return out.transpose(1, 0, 2, 3, 4).reshape(B, S, H, dv)


def spatial_gating(u, v, ln_g, ln_b, w_s, b_s):
    B, S, _ = u.shape
    nc = S // CHUNK
    vn = layernorm(v, ln_g, ln_b).reshape(B, nc, CHUNK, N_HEADS_C, HEAD_DIM)
    tri = jnp.tril(jnp.ones((CHUNK, CHUNK), dtype=bool))
    wm = jnp.where(tri[None], w_s, jnp.zeros((), w_s.dtype))
    y = jnp.einsum('gij,bcjge->bcige', wm, vn) + jnp.transpose(b_s)[None, None, :, :, None]
    return u * y.reshape(B, S, WIDTH_C)


def conv_gated_mlp(h, w_up, conv_w, conv_b, w_down):
    up = h @ w_up
    hp = jnp.pad(up, ((0, 0), (CONV_WIDTH - 1, 0), (0, 0)))
    S = up.shape[1]
    c = conv_b + sum(conv_w[i] * hp[:, i:i + S] for i in range(CONV_WIDTH))
    gate, val = jnp.split(c, 2, axis=-1)
    return (jax.nn.silu(gate) * val) @ w_down


def setup_inputs(seed: int = 0) -> dict:
    key = jax.random.key(seed)
    ks = jax.random.split(key, 20)
    f = jnp.float32
    nrm = lambda k, shape, s: jax.random.normal(k, shape, f) * s
    return {
        "x": nrm(ks[0], (BATCH, SEQ, D_MODEL), 1.0),
        "norm_mix": 1.0 + nrm(ks[1], (DEPTH, D_MODEL), 0.02),
        "w_in": nrm(ks[2], (DEPTH, D_MODEL, IN_COLS), D_MODEL ** -0.5),
        "lambda_q1": nrm(ks[3], (DEPTH, DIFF_QK_DIM), 0.1),
        "lambda_k1": nrm(ks[4], (DEPTH, DIFF_QK_DIM), 0.1),
        "lambda_q2": nrm(ks[5], (DEPTH, DIFF_QK_DIM), 0.1),
        "lambda_k2": nrm(ks[6], (DEPTH, DIFF_QK_DIM), 0.1),
        "diff_subln": 1.0 + nrm(ks[7], (DEPTH, HEAD_DIM), 0.02),
        "sgu_ln_g": 1.0 + nrm(ks[8], (DEPTH, WIDTH_C), 0.02),
        "sgu_ln_b": nrm(ks[9], (DEPTH, WIDTH_C), 0.02),
        "sgu_w": nrm(ks[10], (DEPTH, N_HEADS_C, CHUNK, CHUNK), CHUNK ** -0.5),
        "sgu_b": 1.0 + nrm(ks[11], (DEPTH, N_HEADS_C, CHUNK), 0.02),
        "w_out": nrm(ks[12], (DEPTH, MIX_WIDTH, D_MODEL), MIX_WIDTH ** -0.5),
        "norm_ffn": 1.0 + nrm(ks[13], (DEPTH, D_MODEL), 0.02),
        "w_up": nrm(ks[14], (DEPTH, D_MODEL, 2 * FFN_DIM), D_MODEL ** -0.5),
        "conv_w": nrm(ks[15], (DEPTH, CONV_WIDTH, 2 * FFN_DIM), CONV_WIDTH ** -0.5),
        "conv_b": nrm(ks[16], (DEPTH, 2 * FFN_DIM), 0.01),
        "w_down": nrm(ks[17], (DEPTH, FFN_DIM, D_MODEL), FFN_DIM ** -0.5),
        "norm_final": 1.0 + nrm(ks[18], (D_MODEL,), 0.02),
    }


def reference(x, norm_mix, w_in, lambda_q1, lambda_k1, lambda_q2, lambda_k2, diff_subln,
              sgu_ln_g, sgu_ln_b, sgu_w, sgu_b, w_out, norm_ffn, w_up, conv_w, conv_b, w_down,
              norm_final):
    B, S, _ = x.shape
    cos_a, sin_a = rope_tables(S, HEAD_DIM)
    cos_b, sin_b = rope_tables(S, DIFF_QK_DIM)
    splits = np.cumsum([WIDTH_A, WIDTH_A, WIDTH_A, WIDTH_B, WIDTH_B, WIDTH_B, WIDTH_C])
    for l in range(DEPTH):
        h = rmsnorm(x, norm_mix[l])
        proj = h @ w_in[l]
        qa, ka, va, qb, kb, vb, u, v = jnp.split(proj, splits, axis=-1)
        qa = rope_partial(qa.reshape(B, S, N_HEADS_A, HEAD_DIM), cos_a, sin_a)
        ka = rope_partial(ka.reshape(B, S, N_HEADS_A, HEAD_DIM), cos_a, sin_a)
        va = va.reshape(B, S, N_HEADS_A, HEAD_DIM)
        out_a = dilated_mixture(qa, ka, va).reshape(B, S, WIDTH_A)
        qb = qb.reshape(B, S, N_HEADS_B, 2, DIFF_QK_DIM)
        kb = kb.reshape(B, S, N_HEADS_B, 2, DIFF_QK_DIM)
        q1 = rope_partial(qb[..., 0, :], cos_b, sin_b)
        q2 = rope_partial(qb[..., 1, :], cos_b, sin_b)
        k1 = rope_partial(kb[..., 0, :], cos_b, sin_b)
        k2 = rope_partial(kb[..., 1, :], cos_b, sin_b)
        lambda_init = 0.8 - 0.6 * math.exp(-0.3 * l)
        lam = (jnp.exp(jnp.sum(lambda_q1[l].astype(jnp.float32) * lambda_k1[l].astype(jnp.float32)))
               - jnp.exp(jnp.sum(lambda_q2[l].astype(jnp.float32) * lambda_k2[l].astype(jnp.float32)))
               + lambda_init)
        ob = diff_attention(q1, q2, k1, k2, vb.reshape(B, S, N_HEADS_B, HEAD_DIM), lam)
        out_b = (rmsnorm(ob, diff_subln[l]) * (1.0 - lambda_init)).reshape(B, S, WIDTH_B)
        out_c = spatial_gating(jax.nn.gelu(u, approximate=False), jax.nn.gelu(v, approximate=False),
                               sgu_ln_g[l], sgu_ln_b[l], sgu_w[l], sgu_b[l])
        mix = jnp.concatenate([out_a, out_b.astype(x.dtype), out_c], axis=-1)
        x = x + mix @ w_out[l]
        x = x + conv_gated_mlp(rmsnorm(x, norm_ffn[l]), w_up[l], conv_w[l], conv_b[l], w_down[l])
    return rmsnorm(x, norm_final)
```

```cpp
#include <hip/hip_runtime.h>
#include <hip/hip_cooperative_groups.h>
#include <cstdio>
#include <cstdint>
#define USE_TR 1


namespace cg = cooperative_groups;

#define LAS __attribute__((address_space(3)))
typedef unsigned short bf16_t;
typedef short bf16x8 __attribute__((ext_vector_type(8)));
typedef float f32x4 __attribute__((ext_vector_type(4)));
typedef float f32x2 __attribute__((ext_vector_type(2)));
typedef float f32x16 __attribute__((ext_vector_type(16)));
typedef unsigned u32x4 __attribute__((ext_vector_type(4)));
typedef unsigned u32x2 __attribute__((ext_vector_type(2)));
typedef short s16x4 __attribute__((ext_vector_type(4)));

constexpr int SEQ = 8192, DM = 2048, DEPTH = 4, INC = 5632, FFN = 5632, UPC = 11264;
constexpr int LDP = INC;
constexpr int C_QA = 0, C_KA = 768, C_VA = 1536, C_QB = 2304, C_KB = 3072, C_VB = 3840, C_U = 4608, C_V = 5120;
constexpr int HLD = 128;
constexpr size_t HSZ = (size_t)SEQ * HLD;
constexpr float EPS = 1e-6f;
constexpr float SCALE_A = 0.12751743082459868f;
constexpr float SCALE_B = 0.18033688011112042f;
constexpr float NEGBIG = -1e30f;

constexpr size_t MiB = 1u << 20;
constexpr size_t SZ_WIN = (size_t)INC * DM * 2, SZ_WOUT = (size_t)DM * DM * 2, SZ_WUP = (size_t)UPC * DM * 2, SZ_WDN = (size_t)DM * FFN * 2;
constexpr size_t WS_WIN = 0;
constexpr size_t WS_WOUT = WS_WIN + 4 * SZ_WIN;
constexpr size_t WS_WUP = WS_WOUT + 4 * SZ_WOUT;
constexpr size_t WS_WDN = WS_WUP + 4 * SZ_WUP;
constexpr size_t WS_XB0 = WS_WDN + 4 * SZ_WDN;
constexpr size_t XB_PAD = (size_t)256 * DM * 2;
constexpr size_t WS_P = WS_XB0 + (size_t)(SEQ + 512) * DM * 2;
constexpr size_t WS_MIX = WS_P + (size_t)SEQ * INC * 2;
constexpr size_t WS_UP = WS_MIX + (size_t)SEQ * DM * 2;
constexpr size_t WS_ACT = WS_UP + (size_t)SEQ * UPC * 2;
constexpr size_t WS_SS = WS_ACT + (size_t)SEQ * FFN * 2;
constexpr size_t WS_TABA = WS_SS + (size_t)9 * SEQ * 32 * 4;
constexpr size_t WS_TABB = WS_TABA + (size_t)SEQ * 16 * 8;
constexpr size_t WS_O1 = WS_TABB + (size_t)SEQ * 8 * 8;
constexpr size_t WS_BAR = WS_O1 + (size_t)1024 * 32768;
constexpr size_t WS_HQKV = WS_BAR + 16384;
constexpr size_t WS_END = WS_HQKV + (size_t)36 * SEQ * 128 * 2;

constexpr int LDS_BYTES = 160832;
constexpr int NTHREADS = 512;
constexpr int LDS_RSTD = 159744, LDS_XB = 160768;

namespace pg8 {
constexpr int BM = 256, BK = 64, HALF = 128, HTB = HALF * BK * 2, STAGE_BYTES = 8 * HTB, NXCD = 8, WGM = 8;
__host__ __device__ __forceinline__ int lds_byte(int r, int c) { const int st = (r >> 4) * 2 + (c >> 5), rr = r & 15, cc = c & 31, ob = rr * 64 + cc * 2; return st * 1024 + (ob ^ (((ob >> 9) & 1) << 5)); }
__host__ __device__ __forceinline__ void stage_rc(int b, int& R, int& C) { const int st = b / 1024, sb = b % 1024, swz = sb ^ (((sb >> 9) & 1) << 5); R = (st >> 1) * 16 + swz / 64; C = (st & 1) * 32 + (swz % 64) / 2; }
__host__ __device__ __forceinline__ int perm32(int rho) { const int n = rho >> 4, i = rho & 15; return 8 * (i >> 2) + 4 * n + (i & 3); }

struct Unit { int pm, pn; };
struct Gemm { const bf16_t* A; const bf16_t* Bt; int nM, nN, K; int arows; };

struct StaticOrder {
    int nM, nN, nwg, G, c;
    __device__ void init(int nM_, int nN_, int G_, int c_) { nM = nM_; nN = nN_; nwg = nM * nN; G = G_; c = c_; }
    __device__ bool next(int i, Unit& u) const {
        const long L = (long)i * G + c; if (L >= nwg) return false;
        int wgid = (int)L; { const int q = nwg / NXCD, r = nwg % NXCD, xcd = wgid % NXCD, off = wgid / NXCD; wgid = (xcd < r ? xcd * (q + 1) : r * (q + 1) + (xcd - r) * q) + off; }
        const int nig = WGM * nN, gid = wgid / nig, fm = gid * WGM, gsz = (nM - fm) < WGM ? (nM - fm) : WGM;
        u.pm = fm + ((wgid % nig) % gsz); u.pn = (wgid % nig) / gsz; return true;
    }
};

typedef __bf16 bf16x2_hw __attribute__((ext_vector_type(2)));
typedef float f32x2_hw __attribute__((ext_vector_type(2)));
__device__ __forceinline__ unsigned cvt_pk_hw(float lo, float hi) { f32x2_hw v = {lo, hi}; bf16x2_hw b = __builtin_convertvector(v, bf16x2_hw); return __builtin_bit_cast(unsigned, b); }
__device__ __forceinline__ unsigned cvt_pk_bf16(float lo, float hi) { unsigned r; asm volatile("v_cvt_pk_bf16_f32 %0, %1, %2" : "=v"(r) : "v"(lo), "v"(hi)); return r; }
__device__ __forceinline__ f32x2 gelu_pk(f32x2 v) {
    const f32x2 av = __builtin_elementwise_abs(v), d = av * 0.2316418882f + 1.0f;
    f32x2 t; t.x = __builtin_amdgcn_rcpf(d.x); t.y = __builtin_amdgcn_rcpf(d.y);
    f32x2 q = t * 0.5307027145f + (-0.7265760135f); q = q * t + 0.7107068705f; q = q * t + (-0.142248368f); q = q * t + 0.127414796f; q = q * t;
    const f32x2 s = (v * v) * (-0.72134752044f);
    f32x2 e; e.x = __builtin_amdgcn_exp2f(s.x); e.y = __builtin_amdgcn_exp2f(s.y);
    const f32x2 m = v * (q * e), r = v - m;
    f32x2 o; o.x = v.x < 0.f ? m.x : r.x; o.y = v.y < 0.f ? m.y : r.y; return o;
}

template <class Epi, bool ALIGN_EPI = true>
__device__ __forceinline__ void gemm_phase(LAS unsigned char* lds, const Gemm g, const StaticOrder& S, const Epi& E, const int tid) {
    const int wid = __builtin_amdgcn_readfirstlane(tid >> 6), lane = tid & 63, wr = wid >> 2, wc = wid & 3, fr = lane & 15, fq = lane >> 4;
    const int K = g.K, nt = K / BK;
    unsigned voffA[2], voffB[2];
#pragma unroll
    for (int i = 0; i < 2; ++i) { int R, C; stage_rc(tid * 16 + i * 8192, R, C); const int Rb = Epi::PERM ? ((R & ~31) + perm32(R & 31)) : R;
        voffA[i] = (unsigned)(R * K + C) * 2u; voffB[i] = (unsigned)(Rb * K + C) * 2u; }
    const size_t kstep = (size_t)(BK * 2);
    const size_t hstep = (size_t)HALF * K * 2;
    const size_t tstepB = 2 * hstep;
    const size_t tstepA = (size_t)g.arows * K * 2;
    const unsigned ldsw = (unsigned)wid * 1024u;
    const int aoff = lds_byte(wr * 64 + fr, fq * 8), boff = lds_byte(wc * 32 + fr, fq * 8);
#define PG8_SA(b, h) (((b) * 2 + (h)) * HTB)
#define PG8_SB(b, h) ((4 + (b) * 2 + (h)) * HTB)
#define PG8_STAGE(bufoff, gbase, voff) do { _Pragma("unroll") for (int _i = 0; _i < 2; ++_i) \
        __builtin_amdgcn_global_load_lds((const unsigned*)((const char*)(gbase) + (voff)[_i]), (LAS unsigned*)(lds + (bufoff) + ldsw + _i * 8192), 16, 0, 0); } while (0)
#define PG8_LDA(dst, b, h) do { _Pragma("unroll") for (int m = 0; m < 4; ++m) _Pragma("unroll") for (int k = 0; k < 2; ++k) dst[m][k] = *(const LAS bf16x8*)(lds + PG8_SA(b, h) + aoff + m * 2048 + k * 1024); } while (0)
#define PG8_LDB(dst, b, h) do { _Pragma("unroll") for (int n = 0; n < 2; ++n) _Pragma("unroll") for (int k = 0; k < 2; ++k) dst[n][k] = *(const LAS bf16x8*)(lds + PG8_SB(b, h) + boff + n * 2048 + k * 1024); } while (0)
#define PG8_MMA(ai, bj, At, Bt) do { __builtin_amdgcn_s_setprio(1); _Pragma("unroll") for (int m = 0; m < 4; ++m) _Pragma("unroll") for (int n = 0; n < 2; ++n) _Pragma("unroll") for (int k = 0; k < 2; ++k) \
        acc[ai][bj][m][n] = __builtin_amdgcn_mfma_f32_16x16x32_bf16(Bt[n][k], At[m][k], acc[ai][bj][m][n], 0, 0, 0); __builtin_amdgcn_s_setprio(0); } while (0)
#define PG8_WAIT_V(n) asm volatile("s_waitcnt vmcnt(" #n ")" ::: "memory")
#define PG8_WAIT_L(n) asm volatile("s_waitcnt lgkmcnt(" #n ")" ::: "memory")
#define PG8_BAR __builtin_amdgcn_s_barrier()
#define PG8_SCHED __builtin_amdgcn_sched_barrier(0)
    Unit cur, nxt; int ui = 0;
    if (!S.next(0, cur)) return;
    f32x4 acc[2][2][4][2];
#pragma unroll
    for (int a = 0; a < 2; ++a)
#pragma unroll
        for (int b = 0; b < 2; ++b)
#pragma unroll
            for (int m = 0; m < 4; ++m)
#pragma unroll
                for (int n = 0; n < 2; ++n) acc[a][b][m][n] = (f32x4){0.f, 0.f, 0.f, 0.f};
    bf16x8 At[4][2], B0[2][2], B1[2][2];
    const char* cA = (const char*)g.A + (size_t)cur.pm * tstepA; const char* cB = (const char*)g.Bt + (size_t)cur.pn * tstepB;
    PG8_STAGE(PG8_SB(0, 0), cB, voffB); PG8_STAGE(PG8_SB(0, 1), cB + hstep, voffB); PG8_STAGE(PG8_SA(0, 0), cA, voffA); PG8_STAGE(PG8_SA(0, 1), cA + hstep, voffA);
    if (wr == 1) PG8_BAR;
    PG8_WAIT_V(2); PG8_BAR;
    PG8_STAGE(PG8_SB(1, 0), cB + kstep, voffB); PG8_STAGE(PG8_SA(1, 0), cA + kstep, voffA); PG8_STAGE(PG8_SB(1, 1), cB + hstep + kstep, voffB);
    PG8_WAIT_V(6); PG8_BAR;
    for (;;) {
        const bool has_next = S.next(ui + 1, nxt);
        const char* nA = has_next ? (const char*)g.A + (size_t)nxt.pm * tstepA : cA; const char* nB = has_next ? (const char*)g.Bt + (size_t)nxt.pn * tstepB : cB;
        for (int t = 0; t < nt; t += 2) {
            const bool last = (t == nt - 2);
            const char* a1 = cA + (size_t)(t + 1) * kstep;
            const char* a2 = last ? nA : cA + (size_t)(t + 2) * kstep; const char* b2 = last ? nB : cB + (size_t)(t + 2) * kstep;
            const char* a3 = a2 + kstep; const char* b3 = b2 + kstep;
            PG8_LDB(B0, 0, 0); PG8_LDB(B1, 0, 1); PG8_SCHED; PG8_LDA(At, 0, 0); PG8_STAGE(PG8_SA(1, 1), a1 + hstep, voffA);
            PG8_WAIT_V(8); PG8_WAIT_L(0); PG8_BAR; PG8_MMA(0, 0, At, B0); PG8_MMA(0, 1, At, B1); PG8_BAR; PG8_SCHED;
            PG8_LDA(At, 0, 1); PG8_STAGE(PG8_SB(0, 0), b2, voffB); PG8_STAGE(PG8_SB(0, 1), b2 + hstep, voffB); PG8_STAGE(PG8_SA(0, 0), a2, voffA);
            PG8_WAIT_V(8); PG8_WAIT_L(0); PG8_BAR; PG8_MMA(1, 0, At, B0); PG8_MMA(1, 1, At, B1); PG8_BAR; PG8_SCHED;
            PG8_LDB(B0, 1, 0); PG8_LDB(B1, 1, 1); PG8_SCHED; PG8_LDA(At, 1, 0); PG8_STAGE(PG8_SA(0, 1), a2 + hstep, voffA);
            PG8_WAIT_V(8); PG8_WAIT_L(0); PG8_BAR; PG8_MMA(0, 0, At, B0); PG8_MMA(0, 1, At, B1); PG8_BAR; PG8_SCHED;
            PG8_LDA(At, 1, 1); PG8_STAGE(PG8_SB(1, 0), b3, voffB); PG8_STAGE(PG8_SB(1, 1), b3 + hstep, voffB); PG8_STAGE(PG8_SA(1, 0), a3, voffA);
            PG8_WAIT_V(8); PG8_WAIT_L(0); PG8_BAR; PG8_MMA(1, 0, At, B0); PG8_MMA(1, 1, At, B1); PG8_BAR; PG8_SCHED;
        }
        if constexpr (ALIGN_EPI) { if (wr == 0) PG8_BAR; }
        E(acc, cur, wr, wc, fr, fq);
        if (!has_next) break;
#pragma unroll
        for (int a = 0; a < 2; ++a)
#pragma unroll
            for (int b = 0; b < 2; ++b)
#pragma unroll
                for (int m = 0; m < 4; ++m)
#pragma unroll
                    for (int n = 0; n < 2; ++n) acc[a][b][m][n] = (f32x4){0.f, 0.f, 0.f, 0.f};
        cur = nxt; cA = nA; cB = nB; ++ui;
        if constexpr (ALIGN_EPI) { if (wr == 1) PG8_BAR; }
    }
    PG8_WAIT_V(0);
    if constexpr (!ALIGN_EPI) { if (wr == 0) PG8_BAR; }
    PG8_BAR;
#undef PG8_SA
#undef PG8_SB
#undef PG8_STAGE
#undef PG8_LDA
#undef PG8_LDB
#undef PG8_MMA
#undef PG8_WAIT_V
#undef PG8_WAIT_L
#undef PG8_BAR
#undef PG8_SCHED
}
}
using pg8::cvt_pk_bf16; using pg8::cvt_pk_hw;
#define CFENCE() asm volatile("" ::: "memory")
__device__ __forceinline__ float ss_sum(const float* ssrow) {
    const f32x4* q = (const f32x4*)ssrow; float s = 0.f;
#pragma unroll
    for (int i = 0; i < 8; ++i) { const f32x4 v = q[i]; s += (v[0] + v[1]) + (v[2] + v[3]); }
    return s;
}

__device__ __forceinline__ void rstd_table(const float* ss, int row0, float scale, int wr, int wc, int fr, int fq) {
    extern __shared__ __attribute__((aligned(16))) unsigned char lds_raw_[];
    LAS float* tab = (LAS float*)((LAS unsigned char*)lds_raw_ + LDS_RSTD);
    const int t = (wr * 4 + wc) * 64 + fq * 16 + fr;
    const f32x4* q = (const f32x4*)(ss + (size_t)(row0 + (t >> 1)) * 32) + 4 * (t & 1);
    const f32x4 a = q[0], b = q[1], c = q[2], d = q[3];
    float s = ((a[0] + a[1]) + (a[2] + a[3])) + ((b[0] + b[1]) + (b[2] + b[3])) + ((c[0] + c[1]) + (c[2] + c[3])) + ((d[0] + d[1]) + (d[2] + d[3]));
    const float o = __shfl_xor(s, 1);
    s = (t & 1) ? (o + s) : (s + o);
    if ((t & 1) == 0) tab[t >> 1] = rsqrtf(s * (1.0f / DM) + EPS) * scale;
    asm volatile("s_waitcnt lgkmcnt(0)" ::: "memory"); __builtin_amdgcn_s_barrier(); asm volatile("" ::: "memory");
}
__device__ __forceinline__ float rstd_get(int rloc) {
    extern __shared__ __attribute__((aligned(16))) unsigned char lds_raw_[];
    return ((const LAS float*)((LAS unsigned char*)lds_raw_ + LDS_RSTD))[rloc];
}
struct EpiInProj {
    static constexpr bool PERM = true;
    bf16_t* P; bf16_t* Hq; const float* ss; const f32x2* tabA; const f32x2* tabB;
    __device__ __forceinline__ void operator()(const f32x4 (&acc)[2][2][4][2], const pg8::Unit& u, int wr, int wc, int fr, int fq) const {
        const int row0 = u.pm * 256 + wr * 64 + fr, col0 = u.pn * 256 + wc * 32 + 8 * fq;
        const int ty = u.pn / 3;
        const bool ropeA = (ty == 0 || ty == 1) && wc == 0;
        const bool ropeB = (ty == 3 || ty == 4) && ((wc & 1) == 0);
        const float sc = (ty == 0) ? SCALE_A : (ty == 3) ? SCALE_B : 1.0f;
        rstd_table(ss, u.pm * 256, sc, wr, wc, fr, fq);
#pragma unroll
        for (int ai = 0; ai < 2; ++ai) {
#pragma unroll
          for (int mh = 0; mh < 2; ++mh) {
            f32x4 tb[4][4];
            if (ropeA || ropeB) {
#pragma unroll
                for (int m = 2 * mh; m < 2 * mh + 2; ++m) { const int row = row0 + ai * 128 + m * 16;
                    const f32x4* tp = ropeA ? (const f32x4*)(tabA + (size_t)row * 16 + 8 * (fq & 1)) : (const f32x4*)(tabB + (size_t)row * 8);
#pragma unroll
                    for (int j = 0; j < 4; ++j) tb[m][j] = tp[j]; }
            }
            CFENCE();
#pragma unroll
            for (int m = 2 * mh; m < 2 * mh + 2; ++m) {
                const int row = row0 + ai * 128 + m * 16;
                const float rstd = rstd_get(wr * 64 + fr + ai * 128 + m * 16);
                bf16_t* rowp = (ty < 6) ? Hq + ((size_t)(ty * 6 + (u.pn % 3) * 2) * SEQ + row) * HLD + wc * 32 + 8 * fq : P + (size_t)row * LDP + col0;
                const size_t bjstep = (ty < 6) ? HSZ : (size_t)128;
#pragma unroll
                for (int bj = 0; bj < 2; ++bj) {
                    float v[8];
#pragma unroll
                    for (int e = 0; e < 4; ++e) { v[e] = acc[ai][bj][m][0][e] * rstd; v[4 + e] = acc[ai][bj][m][1][e] * rstd; }
                    if (ropeA) {
                        const float sg = (fq < 2) ? -1.f : 1.f;
#pragma unroll
                        for (int e = 0; e < 8; ++e) { const float pv = __shfl_xor(v[e], 32); const float cx = tb[m][e >> 1][2 * (e & 1)], sy = tb[m][e >> 1][2 * (e & 1) + 1]; v[e] = v[e] * cx + sg * pv * sy; }
                    } else if (ropeB) {
                        const float sg = (fq == 0) ? -1.f : 1.f;
#pragma unroll
                        for (int e = 0; e < 8; ++e) { const float pv = __shfl_xor(v[e], 16); const float cx = tb[m][e >> 1][2 * (e & 1)], sy = tb[m][e >> 1][2 * (e & 1) + 1]; const float r = v[e] * cx + sg * pv * sy; v[e] = (fq < 2) ? r : v[e]; }
                    } else if (ty >= 6) {
#pragma unroll
                        for (int e = 0; e < 8; e += 2) { const f32x2 gg = pg8::gelu_pk((f32x2){v[e], v[e + 1]}); v[e] = gg.x; v[e + 1] = gg.y; }
                    }
                    u32x4 w; w.x = cvt_pk_bf16(v[0], v[1]); w.y = cvt_pk_bf16(v[2], v[3]); w.z = cvt_pk_bf16(v[4], v[5]); w.w = cvt_pk_bf16(v[6], v[7]);
                    *(u32x4*)(rowp + bj * bjstep) = w;
                }
                CFENCE();
            }
          }
        }
    }
};
struct EpiResid {
    static constexpr bool PERM = true;
    float* x; bf16_t* xb; float* ssn;
    __device__ __forceinline__ void operator()(const f32x4 (&acc)[2][2][4][2], const pg8::Unit& u, int wr, int wc, int fr, int fq) const {
        const int row0 = u.pm * 256 + wr * 64 + fr, col0 = u.pn * 256 + wc * 32 + 8 * fq;
#pragma unroll
        for (int ai = 0; ai < 2; ++ai) {
            f32x4 pre[4][2][2];
#pragma unroll
            for (int m = 0; m < 4; ++m) { const float* xr = x + (size_t)(row0 + ai * 128 + m * 16) * DM + col0;
#pragma unroll
                for (int bj = 0; bj < 2; ++bj) { pre[m][bj][0] = *(const f32x4*)(xr + bj * 128); pre[m][bj][1] = *(const f32x4*)(xr + bj * 128 + 4); } }
            CFENCE();
#pragma unroll
            for (int m = 0; m < 4; ++m) {
                const int row = row0 + ai * 128 + m * 16;
                float* xr = x + (size_t)row * DM + col0; bf16_t* br = xb + (size_t)row * DM + col0;
                float s = 0.f;
#pragma unroll
                for (int bj = 0; bj < 2; ++bj) {
                    const f32x4 a = pre[m][bj][0] + acc[ai][bj][m][0], b = pre[m][bj][1] + acc[ai][bj][m][1];
                    *(f32x4*)(xr + bj * 128) = a; *(f32x4*)(xr + bj * 128 + 4) = b;
                    s += (a[0] * a[0] + a[1] * a[1]) + (a[2] * a[2] + a[3] * a[3]) + (b[0] * b[0] + b[1] * b[1]) + (b[2] * b[2] + b[3] * b[3]);
                    u32x4 w; w.x = cvt_pk_bf16(a[0], a[1]); w.y = cvt_pk_bf16(a[2], a[3]); w.z = cvt_pk_bf16(b[0], b[1]); w.w = cvt_pk_bf16(b[2], b[3]);
                    *(u32x4*)(br + bj * 128) = w;
                }
                s += __shfl_xor(s, 16); s += __shfl_xor(s, 32);
                if (fq == 0) ssn[(size_t)row * 32 + u.pn * 4 + wc] = s;
            }
            CFENCE();
        }
    }
};
struct EpiUpRaw {
    static constexpr bool PERM = true;
    bf16_t* O; const float* ss;
    __device__ __forceinline__ void operator()(const f32x4 (&acc)[2][2][4][2], const pg8::Unit& u, int wr, int wc, int fr, int fq) const {
        const int row0 = u.pm * 256 + wr * 64 + fr, col0 = u.pn * 256 + wc * 32 + 8 * fq;
        rstd_table(ss, u.pm * 256, 1.0f, wr, wc, fr, fq);
#pragma unroll
        for (int ai = 0; ai < 2; ++ai)
#pragma unroll
            for (int m = 0; m < 4; ++m) {
                const int row = row0 + ai * 128 + m * 16;
                const float rstd = rstd_get(wr * 64 + fr + ai * 128 + m * 16);
                bf16_t* rowp = O + (size_t)row * UPC + col0;
#pragma unroll
                for (int bj = 0; bj < 2; ++bj) {
                    const f32x4 v0 = acc[ai][bj][m][0] * rstd, v1 = acc[ai][bj][m][1] * rstd;
                    u32x4 w; w.x = cvt_pk_bf16(v0[0], v0[1]); w.y = cvt_pk_bf16(v0[2], v0[3]); w.z = cvt_pk_bf16(v1[0], v1[1]); w.w = cvt_pk_bf16(v1[2], v1[3]);
                    *(u32x4*)(rowp + bj * 128) = w;
                }
                CFENCE();
            }
    }
};

constexpr int LDS_XCH = 131072;
__device__ __forceinline__ float dpp_ror1(float v) { return __int_as_float(__builtin_amdgcn_update_dpp(0, __float_as_int(v), 0x121, 0xF, 0xF, true)); }
__device__ __forceinline__ float dpp_ror2(float v) { return __int_as_float(__builtin_amdgcn_update_dpp(0, __float_as_int(v), 0x122, 0xF, 0xF, true)); }
struct EpiUpConv {
    static constexpr bool PERM = true;
    bf16_t* act; const float* ss; const float* cw; const float* cb;
    __device__ __forceinline__ void operator()(f32x4 (&acc)[2][2][4][2], const pg8::Unit& u, int wr, int wc, int fr, int fq) const {
        extern __shared__ __attribute__((aligned(16))) unsigned char lds_raw_[];
        LAS f32x4* xch = (LAS f32x4*)((LAS unsigned char*)lds_raw_ + LDS_XCH);
        const int R0 = 254 * u.pm - 2;
        rstd_table(ss, R0, 1.0f, wr, wc, fr, fq);
#pragma unroll
        for (int ai = 0; ai < 2; ++ai)
#pragma unroll
            for (int m = 0; m < 4; ++m) { const float rs = rstd_get(wr * 64 + fr + ai * 128 + m * 16);
#pragma unroll
                for (int bj = 0; bj < 2; ++bj) { acc[ai][bj][m][0] = acc[ai][bj][m][0] * rs; acc[ai][bj][m][1] = acc[ai][bj][m][1] * rs; } }
        if (fr >= 14) {
#pragma unroll
            for (int ai = 0; ai < 2; ++ai) { LAS f32x4* d = xch + ((((2 * ai + wr) * 2 + (fr - 14)) * 4 + wc) * 4 + fq) * 4;
                d[0] = acc[ai][0][3][0]; d[1] = acc[ai][0][3][1]; d[2] = acc[ai][1][3][0]; d[3] = acc[ai][1][3][1]; }
        }
        asm volatile("s_waitcnt lgkmcnt(0)" ::: "memory"); __builtin_amdgcn_s_barrier(); asm volatile("" ::: "memory");
        const int j0 = 128 * u.pn + 32 * wc + 8 * fq;
#pragma unroll
        for (int n = 0; n < 2; ++n) {
            f32x4 wg[3], wv[3];
#pragma unroll
            for (int i = 0; i < 3; ++i) { wg[i] = *(const f32x4*)(cw + (size_t)i * UPC + j0 + 4 * n); wv[i] = *(const f32x4*)(cw + (size_t)i * UPC + FFN + j0 + 4 * n); }
            const f32x4 bg = *(const f32x4*)(cb + j0 + 4 * n), bv = *(const f32x4*)(cb + FFN + j0 + 4 * n);
#pragma unroll
            for (int ai = 0; ai < 2; ++ai)
#pragma unroll
                for (int m = 0; m < 4; ++m) {
                    f32x4 pg, pv;
                    if (m > 0) { pg = acc[ai][0][m - 1][n]; pv = acc[ai][1][m - 1][n]; }
                    else { const int sp = 2 * ai + wr - 1;
                        const LAS f32x4* sp_ = xch + ((((sp < 0 ? 0 : sp) * 2 + (fr & 1)) * 4 + wc) * 4 + fq) * 4;
                        pg = sp_[n]; pv = sp_[2 + n]; }
                    const f32x4 g = acc[ai][0][m][n], v = acc[ai][1][m][n];
                    const int rl = 128 * ai + 64 * wr + 16 * m + fr, row = R0 + rl;
                    float o[4];
#pragma unroll
                    for (int e = 0; e < 4; ++e) {
                        const float g1 = dpp_ror1(fr == 15 ? pg[e] : g[e]), g2 = dpp_ror2(fr >= 14 ? pg[e] : g[e]);
                        const float v1 = dpp_ror1(fr == 15 ? pv[e] : v[e]), v2 = dpp_ror2(fr >= 14 ? pv[e] : v[e]);
                        const float cg_ = bg[e] + wg[0][e] * g2 + wg[1][e] * g1 + wg[2][e] * g[e];
                        const float cv_ = bv[e] + wv[0][e] * v2 + wv[1][e] * v1 + wv[2][e] * v[e];
                        o[e] = cg_ * __builtin_amdgcn_rcpf(1.0f + __builtin_amdgcn_exp2f(cg_ * -1.4426950408889634f)) * cv_;
                    }
                    if (rl >= 2 && row < SEQ) { u32x2 w; w.x = cvt_pk_bf16(o[0], o[1]); w.y = cvt_pk_bf16(o[2], o[3]); *(u32x2*)(act + (size_t)row * FFN + j0 + 4 * n) = w; }
                }
        }
    }
};

__device__ __forceinline__ float bf2f(unsigned short b) { return __uint_as_float((unsigned)b << 16); }
__device__ __forceinline__ float wave_sum(float v) {
#pragma unroll
    for (int o = 1; o < 64; o <<= 1) v += __shfl_xor(v, o);
    return v;
}
__device__ __forceinline__ unsigned off_a(unsigned row, unsigned ch) { return 2048u * (row >> 3) + 512u * (ch >> 2) + 64u * (row & 7) + 16u * ((ch & 3) ^ ((row >> 2) & 3)); }
__device__ __forceinline__ unsigned off_b(unsigned row, unsigned ch) { return 256u * row + 16u * (ch ^ (((row & 3) << 2) | ((row >> 2) & 3))); }
__device__ __forceinline__ int crow(int r, int hi) { return (r & 3) + 8 * (r >> 2) + 4 * hi; }
__device__ __forceinline__ s16x4 vtr(const LAS char* p) { return __builtin_bit_cast(s16x4, __builtin_amdgcn_ds_read_tr16_b64_v4i16((LAS s16x4*)p)); }


typedef unsigned v4u_xb __attribute__((ext_vector_type(4)));
#define XB_TMO      128
#define XB_XCNT(j)  (256  + 64 * (j))
#define XB_XSUB(j)  (1280 + 64 * (j))
#define XB_XGEN(j)  (2304 + 64 * (j))
#define XB_TOP      3328
#define XB_TOPGEN   3392
#define XCD_BAR_WORDS 3456
#define XB_SPIN_CAP (1u << 22)
__device__ __forceinline__ unsigned xb_ld(unsigned* p)              { return __hip_atomic_load(p, __ATOMIC_RELAXED, __HIP_MEMORY_SCOPE_AGENT); }
__device__ __forceinline__ unsigned xb_add(unsigned* p, unsigned v) { return __hip_atomic_fetch_add(p, v, __ATOMIC_RELAXED, __HIP_MEMORY_SCOPE_AGENT); }
__device__ __forceinline__ unsigned xb_xcc_id() { return (unsigned)__builtin_amdgcn_s_getreg((3 << 11) | 20) & 0xFu; }
#define XB_SPIN(cond, bar) do { unsigned _sp = 0; while (cond) { __builtin_amdgcn_s_sleep(1); \
    if ((++_sp & 255u) == 0u) { if (xb_ld(&(bar)[XB_TMO])) break; if (_sp > XB_SPIN_CAP) { atomicAdd(&(bar)[XB_TMO], 1u); break; } } } } while (0)
struct XcdBarrier { unsigned* bar; unsigned x; volatile LAS unsigned* st; };
__device__ __forceinline__ XcdBarrier xcd_barrier_post(unsigned* bar, volatile LAS unsigned* st, int tid) {
    XcdBarrier b; b.bar = bar; b.x = xb_xcc_id(); b.st = st;
    if (tid == 0) (void)xb_add(&bar[XB_XCNT(b.x)], 1u);
    return b;
}
__device__ __forceinline__ void xcd_barrier_complete(unsigned* bar, unsigned x, unsigned& nloc, unsigned& nx) {
    const unsigned G = gridDim.x * gridDim.y * gridDim.z;
    unsigned sum, cnt, mine, sp = 0u;
    for (;;) {
        sum = 0u; cnt = 0u; mine = 0u;
#pragma unroll
        for (unsigned j = 0; j < 16; ++j) { const unsigned c = xb_ld(&bar[XB_XCNT(j)]); sum += c; cnt += (c > 0u) ? 1u : 0u; mine = (j == x) ? c : mine; }
        if (sum == G) break;
        __builtin_amdgcn_s_sleep(1);
        if ((++sp & 255u) == 0u) { if (xb_ld(&bar[XB_TMO])) break; if (sp > XB_SPIN_CAP) { atomicAdd(&bar[XB_TMO], 1u); break; } }
    }
    nloc = mine > 0u ? mine : 1u; nx = cnt > 0u ? cnt : 1u;
}
__device__ __forceinline__ void xcd_barrier(const XcdBarrier& b, int tid) {
    asm volatile("s_waitcnt vmcnt(0)" ::: "memory");
    __syncthreads();
    if (tid == 0) {
        unsigned* bar = b.bar;
        __builtin_amdgcn_s_waitcnt(0);
        unsigned nloc = b.st[0], nx = b.st[1];
        if (nloc == 0u) { xcd_barrier_complete(bar, b.x, nloc, nx); b.st[0] = nloc; b.st[1] = nx; }
        const unsigned old = xb_add(&bar[XB_XSUB(b.x)], 1u);
        const unsigned gen = old / nloc;
        if (old + 1u == (gen + 1u) * nloc) {
            __builtin_amdgcn_fence(__ATOMIC_RELEASE, "agent");
            asm volatile("s_waitcnt vmcnt(0)" ::: "memory");
            const unsigned og = xb_add(&bar[XB_TOP], 1u);
            const unsigned tg = og / nx;
            if (og + 1u == (tg + 1u) * nx) xb_add(&bar[XB_TOPGEN], 1u);
            else XB_SPIN(xb_ld(&bar[XB_TOPGEN]) == tg, bar);
            __builtin_amdgcn_fence(__ATOMIC_ACQUIRE, "agent");
            xb_add(&bar[XB_XGEN(b.x)], 1u);
            asm volatile("s_waitcnt vmcnt(0)" ::: "memory");
        } else {
            XB_SPIN(xb_ld(&bar[XB_XGEN(b.x)]) == gen, bar);
            __builtin_amdgcn_fence(__ATOMIC_ACQUIRE, "agent");
            asm volatile("s_waitcnt vmcnt(0)" ::: "memory");
        }
    }
    __syncthreads();
}

struct Params {
    const float* in[19];
    float* out; unsigned char* ws;
    int ph_lo, ph_hi;
};

__device__ __forceinline__ void transpose_item(const float* W, int K, int N, bf16_t* WT, int dst_row0, const float* gscale, LAS float* scr, int k0, int n0, int lane) {
    f32x4 v[16];
    const int kr = lane >> 4, c4 = 4 * (lane & 15);
#pragma unroll
    for (int i = 0; i < 16; ++i) v[i] = *(const f32x4*)(W + (size_t)(k0 + 4 * i + kr) * N + n0 + c4);
#pragma unroll
    for (int i = 0; i < 16; ++i) { const int kk = 4 * i + kr; const float g = gscale ? gscale[k0 + kk] : 1.0f; LAS float* d = scr + kk * 65 + c4;
        d[0] = v[i][0] * g; d[1] = v[i][1] * g; d[2] = v[i][2] * g; d[3] = v[i][3] * g; }
    CFENCE();
    const int c = lane & 7;
#pragma unroll
    for (int j = 0; j < 8; ++j) { const int n = (lane >> 3) + 8 * j; const LAS float* s = scr + (8 * c) * 65 + n;
        u32x4 o; o.x = cvt_pk_bf16(s[0 * 65], s[1 * 65]); o.y = cvt_pk_bf16(s[2 * 65], s[3 * 65]); o.z = cvt_pk_bf16(s[4 * 65], s[5 * 65]); o.w = cvt_pk_bf16(s[6 * 65], s[7 * 65]);
        *(u32x4*)(WT + (size_t)(dst_row0 + n) * K + k0 + 8 * c) = o; }
    CFENCE();
}
__device__ __forceinline__ void sincos_d(double a, float& c, float& s) {
    const double TWO_PI = 6.283185307179586476925286766559, INV = 0.15915494309189533576888376337251;
    const double k = __builtin_rint(a * INV); const double r = a - k * TWO_PI;
    const double r2 = r * r;
    double sn = 1.0, cs = 1.0;
    double ts = 1.0, tc = 1.0;
    sn = 0.0; cs = 0.0;
#pragma unroll
    for (int n = 13; n >= 1; --n) { ts = 1.0 - ts * r2 / (double)((2 * n) * (2 * n + 1)); tc = 1.0 - tc * r2 / (double)((2 * n - 1) * (2 * n)); }
    sn = r * ts; cs = tc;
    c = (float)cs; s = (float)sn;
}
__device__ __forceinline__ void prologue(const Params& p, unsigned char* ws, LAS unsigned char* lds, int gw, int NGW, int wid, int lane) {
    LAS float* scr = (LAS float*)(lds + wid * 16640);
    constexpr int I_IN = (DM / 64) * (INC / 64), I_OUT = (DM / 64) * (DM / 64), I_UP = (DM / 64) * (UPC / 64), I_DN = (FFN / 64) * (DM / 64);
    constexpr int I_L = I_IN + I_OUT + I_UP + I_DN;
    for (int it = gw; it < DEPTH * I_L; it += NGW) {
        const int l = it / I_L; int r = it % I_L;
        if (r < I_IN) { const int nb = INC / 64, kb = r / nb, n0 = 64 * (r % nb);
            transpose_item(p.in[2] + (size_t)l * DM * INC, DM, INC, (bf16_t*)(ws + WS_WIN + l * SZ_WIN), n0, p.in[1] + l * DM, scr, 64 * kb, n0, lane); continue; }
        r -= I_IN;
        if (r < I_OUT) { const int nb = DM / 64, kb = r / nb, n0 = 64 * (r % nb);
            transpose_item(p.in[12] + (size_t)l * DM * DM, DM, DM, (bf16_t*)(ws + WS_WOUT + l * SZ_WOUT), n0, nullptr, scr, 64 * kb, n0, lane); continue; }
        r -= I_OUT;
        if (r < I_UP) { const int nb = UPC / 64, kb = r / nb, n0 = 64 * (r % nb);
            const int j = (n0 < FFN) ? n0 : n0 - FFN; const int dst = 256 * (j / 128) + (j % 128) + ((n0 < FFN) ? 0 : 128);
            transpose_item(p.in[14] + (size_t)l * DM * UPC, DM, UPC, (bf16_t*)(ws + WS_WUP + l * SZ_WUP), dst, p.in[13] + l * DM, scr, 64 * kb, n0, lane); continue; }
        r -= I_UP;
        { const int nb = DM / 64, kb = r / nb, n0 = 64 * (r % nb);
            transpose_item(p.in[17] + (size_t)l * FFN * DM, FFN, DM, (bf16_t*)(ws + WS_WDN + l * SZ_WDN), n0, nullptr, scr, 64 * kb, n0, lane); }
    }
    bf16_t* xb = (bf16_t*)(ws + WS_XB0 + XB_PAD); float* ss = (float*)(ws + WS_SS);
    for (int m = gw; m < SEQ; m += NGW) {
        const f32x4* xr = (const f32x4*)(p.in[0] + (size_t)m * DM) + lane; f32x4* orow = (f32x4*)(p.out + (size_t)m * DM) + lane;
        u32x2* brow = (u32x2*)(xb + (size_t)m * DM) + lane; float s = 0.f;
#pragma unroll
        for (int j = 0; j < 8; ++j) { const f32x4 v = xr[64 * j]; orow[64 * j] = v; s += (v[0] * v[0] + v[1] * v[1]) + (v[2] * v[2] + v[3] * v[3]);
            u32x2 w; w.x = cvt_pk_bf16(v[0], v[1]); w.y = cvt_pk_bf16(v[2], v[3]); brow[64 * j] = w; }
        s = wave_sum(s); if (lane < 32) ss[(size_t)m * 32 + lane] = (lane == 0) ? s : 0.f;
    }
    for (int m = gw; m < 512; m += NGW) {
        u32x4* prow = (u32x4*)(ws + WS_XB0 + (m < 256 ? (size_t)m * DM * 2 : XB_PAD + (size_t)(SEQ + m - 256) * DM * 2)) + lane;
#pragma unroll
        for (int j = 0; j < 4; ++j) prow[64 * j] = (u32x4){0u, 0u, 0u, 0u};
    }
    const float invA[16] = {1.000000000e+00f, 4.403666258e-01f, 1.939227581e-01f, 8.539710194e-02f, 3.760603070e-02f, 1.656044088e-02f, 7.292665076e-03f, 3.211446106e-03f,
                            1.414213446e-03f, 6.227724371e-04f, 2.742481884e-04f, 1.207697424e-04f, 5.318296462e-05f, 2.341999789e-05f, 1.031338525e-05f, 4.541670478e-06f};
    f32x2* tabA = (f32x2*)(ws + WS_TABA); f32x2* tabB = (f32x2*)(ws + WS_TABB);
    for (int i = gw * 64 + lane; i < SEQ * 16; i += NGW * 64) {
        const int t = i >> 4, k = i & 15; float inv = 0.f;
#pragma unroll
        for (int q = 0; q < 16; ++q) inv = (k == q) ? invA[q] : inv;
        const float ang = (float)t * inv; float c, s; sincos_d((double)ang, c, s); tabA[i] = (f32x2){c, s};
        if ((k & 1) == 0) tabB[t * 8 + (k >> 1)] = (f32x2){c, s};
    }
}

__device__ __forceinline__ void load_v_regs(u32x4 (&r)[8], const bf16_t* vbase  , int kbase, int kstride, int lane) {
#pragma unroll
    for (int i = 0; i < 8; ++i) { const int cid = lane + 64 * i, row = cid >> 4, ch = cid & 15; int tok = kbase + row * kstride; tok = tok < 0 ? 0 : (tok > SEQ - 1 ? SEQ - 1 : tok);
        r[i] = *(const u32x4*)(vbase + (size_t)tok * LDP + 8 * ch); }
}
__device__ __forceinline__ void store_v_tile(const u32x4 (&r)[8], LAS char* vt, int lane) {
#pragma unroll
    for (int i = 0; i < 8; ++i) { const int cid = lane + 64 * i, row = cid >> 4, ch = cid & 15; *(LAS u32x4*)(vt + off_b(row, ch)) = r[i]; }
    asm volatile("s_waitcnt lgkmcnt(0)" ::: "memory");
}
__device__ __forceinline__ void vfrag_bases(const LAS char* vt, int lane, const LAS char*& vb0, const LAS char*& vb1) {
    const int hi = lane >> 5, blk = (lane >> 4) & 1, q = (lane & 15) >> 2, pp = lane & 3;
    const int c = 2 * blk + (pp >> 1);
    vb0 = vt + 64 * (4 * hi + q) + 16 * (c ^ hi) + 8 * (pp & 1);
    vb1 = vt + 64 * (4 * hi + q) + 16 * (c ^ (2 + hi)) + 8 * (pp & 1);
}
__device__ __forceinline__ bf16x8 vfrag(const LAS char* vb0, const LAS char* vb1, int dt, int ks) {
    const s16x4 lo = vtr(vb0 + 4096 * ks + 512 * dt);
    const s16x4 hv = vtr(vb1 + 4096 * ks + 2048 + 512 * dt);
    return (bf16x8){lo[0], lo[1], lo[2], lo[3], hv[0], hv[1], hv[2], hv[3]};
}
__device__ __forceinline__ void softmax_tile(f32x16& s, float& m, float& l, float& alpha, bf16x8& p0, bf16x8& p1) {
    float tm = s[0];
#pragma unroll
    for (int r = 1; r < 16; ++r) tm = fmaxf(tm, s[r]);
    { auto rr = __builtin_amdgcn_permlane32_swap(__float_as_uint(tm), __float_as_uint(tm), false, false); tm = fmaxf(__uint_as_float(rr[0]), __uint_as_float(rr[1])); }
    const float mn = (tm > m + 16.0f) ? tm : m;
    alpha = __builtin_amdgcn_exp2f(m - mn);
    float rs = 0.f;
#pragma unroll
    for (int r = 0; r < 16; ++r) { s[r] = __builtin_amdgcn_exp2f(s[r] - mn); rs += s[r]; }
    { auto rr = __builtin_amdgcn_permlane32_swap(__float_as_uint(rs), __float_as_uint(rs), false, false); rs = __uint_as_float(rr[0]) + __uint_as_float(rr[1]); }
    l = l * alpha + rs; m = mn;
    u32x4 a, b;
    a.x = cvt_pk_hw(s[0], s[1]); a.y = cvt_pk_hw(s[2], s[3]); a.z = cvt_pk_hw(s[4], s[5]); a.w = cvt_pk_hw(s[6], s[7]);
    b.x = cvt_pk_hw(s[8], s[9]); b.y = cvt_pk_hw(s[10], s[11]); b.z = cvt_pk_hw(s[12], s[13]); b.w = cvt_pk_hw(s[14], s[15]);
    p0 = __builtin_bit_cast(bf16x8, a); p1 = __builtin_bit_cast(bf16x8, b);
}

__device__ __forceinline__ void mixerA_unit(const bf16_t* Hq, bf16_t* mix, int head, int rho, int blk, LAS char* vt, int lane) {
    asm volatile("" : "+v"(lane));
    const int r32 = lane & 31, hi = lane >> 5;
    const int tq = rho + 16 * (32 * blk + r32);
    const bf16_t* qrow = Hq + ((size_t)(0 * 6 + head) * SEQ + tq) * HLD + 8 * hi;
    bf16x8 qf[8];
#pragma unroll
    for (int s = 0; s < 8; ++s) qf[s] = *(const bf16x8*)(qrow + 16 * s);
    f32x16 o[4];
#pragma unroll
    for (int d = 0; d < 4; ++d)
#pragma unroll
        for (int r = 0; r < 16; ++r) o[d][r] = 0.f;
    float m = NEGBIG, l = 0.f;
    const bf16_t* kcol = Hq + (size_t)(1 * 6 + head) * HSZ + 8 * hi;
    const bf16_t* vcol = Hq + (size_t)(2 * 6 + head) * HSZ;
#define A_TILE(it_, kbase_, kstride_, W_) do { if ((it_) < 5) { const int k_ = 4 - (it_); kstride_ = 16; W_ = 2048; kbase_ = rho + 16 * (32 * blk - 128 + 32 * k_); } \
        else if ((it_) < 13) { const int k_ = (it_) - 5; kstride_ = 4; W_ = 512; kbase_ = (rho & 3) + 4 * ((rho >> 2) + 128 * blk - 128 + 32 * k_); } \
        else { const int k_ = (it_) - 13; kstride_ = 1; W_ = 128; kbase_ = rho + 512 * blk - 128 + 32 * k_; } } while (0)
#define A_KLOAD(dst_, kbase_, kstride_) do { int tokk_ = (kbase_) + r32 * (kstride_); tokk_ = tokk_ < 0 ? 0 : (tokk_ > SEQ - 1 ? SEQ - 1 : tokk_); const bf16_t* krow_ = kcol + (size_t)tokk_ * HLD; \
        _Pragma("unroll") for (int s_ = 0; s_ < 8; ++s_) dst_[s_] = *(const bf16x8*)(krow_ + 16 * s_); } while (0)
    const char* vbase_u = (const char*)vcol;
    const unsigned a_rl = (unsigned)((lane >> 2) & 7);
    const unsigned a_cA = (unsigned)(16 * (4 * (lane >> 5) + ((lane & 3) ^ ((lane >> 4) & 1)))), a_cB = (unsigned)(16 * (4 * (lane >> 5) + ((lane & 3) ^ (2 + ((lane >> 4) & 1)))));
#define A_DMA_V(kbase_, kstride_, buf_) do { \
        if ((kbase_) >= 0 && (kbase_) + 31 * (kstride_) <= SEQ - 1) { \
            const char* vg_ = vbase_u + (size_t)(kbase_) * 256; const unsigned rs_ = (unsigned)(kstride_) * 256u; const unsigned oA_ = a_rl * rs_ + a_cA, oB_ = a_rl * rs_ + a_cB; \
            _Pragma("unroll") for (int i_ = 0; i_ < 8; ++i_) \
                __builtin_amdgcn_global_load_lds((const unsigned*)((vg_ + ((size_t)(8 * (i_ >> 1)) * rs_ + 128 * (i_ & 1))) + (((i_ >> 1) & 1) ? oB_ : oA_)), (LAS unsigned*)(vt + (buf_) * 8192 + i_ * 1024), 16, 0, 0); \
        } else { _Pragma("unroll") for (int i_ = 0; i_ < 8; ++i_) { \
            const int row_ = 8 * (i_ >> 1) + ((lane >> 2) & 7); const int ch_ = 4 * (2 * (i_ & 1) + (lane >> 5)) + ((lane & 3) ^ ((row_ >> 2) & 3)); \
            int tokv_ = (kbase_) + row_ * (kstride_); tokv_ = tokv_ < 0 ? 0 : (tokv_ > SEQ - 1 ? SEQ - 1 : tokv_); \
            __builtin_amdgcn_global_load_lds((const unsigned*)(vcol + (size_t)tokv_ * HLD + 8 * ch_), (LAS unsigned*)(vt + (buf_) * 8192 + i_ * 1024), 16, 0, 0); } } } while (0)
    const LAS char *va0, *va1; vfrag_bases((const LAS char*)vt, lane, va0, va1);
    bf16x8 kfn[8];
    int cur = 0;
    { int kb0, ks0, w0; A_TILE(0, kb0, ks0, w0); (void)w0; A_DMA_V(kb0, ks0, 0); A_KLOAD(kfn, kb0, ks0); }
    for (int it = 0; it < 33; ++it) {
        int kbase, kstride, W;
        A_TILE(it, kbase, kstride, W);
        bf16x8 kf[8];
#pragma unroll
        for (int s = 0; s < 8; ++s) kf[s] = kfn[s];
        if (it + 1 < 33) { int kb1, ks1, w1; A_TILE(it + 1, kb1, ks1, w1); (void)w1; A_DMA_V(kb1, ks1, cur ^ 1); A_KLOAD(kfn, kb1, ks1); }
        __builtin_amdgcn_sched_barrier(0);
        f32x16 sc;
#pragma unroll
        for (int r = 0; r < 16; ++r) sc[r] = 0.f;
#pragma unroll
        for (int s = 0; s < 8; ++s) sc = __builtin_amdgcn_mfma_f32_32x32x16_bf16(kf[s], qf[s], sc, 0, 0, 0);
        { const int dbase = tq - kbase - 4 * hi * kstride; const unsigned lim = (unsigned)(W < tq ? W : tq);
#pragma unroll
          for (int r = 0; r < 16; ++r) { const unsigned df = (unsigned)(dbase - ((r & 3) + 8 * (r >> 2)) * kstride); sc[r] = (df <= lim) ? sc[r] : NEGBIG; } }
        float alpha; bf16x8 p0, p1;
        softmax_tile(sc, m, l, alpha, p0, p1);
        if (it + 1 < 33) asm volatile("s_waitcnt vmcnt(16)" ::: "memory"); else asm volatile("s_waitcnt vmcnt(0)" ::: "memory");
        if (__any(alpha != 1.0f)) {
#pragma unroll
            for (int d = 0; d < 4; ++d)
#pragma unroll
                for (int r = 0; r < 16; ++r) o[d][r] *= alpha;
        }
#pragma unroll
        for (int d = 0; d < 4; ++d) {
            const bf16x8 v0 = vfrag(va0 + cur * 8192, va1 + cur * 8192, d, 0), v1 = vfrag(va0 + cur * 8192, va1 + cur * 8192, d, 1);
            o[d] = __builtin_amdgcn_mfma_f32_32x32x16_bf16(v0, p0, o[d], 0, 0, 0);
            o[d] = __builtin_amdgcn_mfma_f32_32x32x16_bf16(v1, p1, o[d], 0, 0, 0);
        }
        CFENCE();
        cur ^= 1;
    }
    const float il = 1.0f / l;
    bf16_t* orow = mix + (size_t)tq * DM + head * 128 + 4 * hi;
#pragma unroll
    for (int d = 0; d < 4; ++d)
#pragma unroll
        for (int g = 0; g < 4; ++g) {
            u32x2 w; w.x = cvt_pk_bf16(o[d][4 * g] * il, o[d][4 * g + 1] * il); w.y = cvt_pk_bf16(o[d][4 * g + 2] * il, o[d][4 * g + 3] * il);
            *(u32x2*)(orow + 32 * d + 8 * g) = w;
        }
}

constexpr int B_TAB_W = 3;
__device__ const unsigned short b_list[8 * 96] = {
127,126,125,124,123,122,121,120,119,118,117,116,115,114,113,112,111,110,109,108,107,106,105,104,103,102,101,100,99,98,97,96,95,94,93,92,91,90,89,88,87,86,85,84,83,82,81,80,47,46,45,44,43,42,41,40,39,38,37,36,35,34,33,32,31,30,29,28,27,26,25,24,23,22,21,20,19,18,17,16,15,14,13,12,11,10,9,8,7,6,5,4,3,2,1,0,
255,254,253,252,251,250,249,248,247,246,245,244,243,242,241,240,239,238,237,236,235,234,233,232,231,230,229,228,227,226,225,224,79,78,77,76,75,74,73,72,71,70,69,68,67,66,65,64,63,62,61,60,59,58,57,56,55,54,53,52,51,50,49,48,159,158,157,156,155,154,153,152,151,150,149,148,147,146,145,144,143,142,141,140,139,138,137,136,135,134,133,132,131,130,129,128,
383,382,381,380,379,378,377,376,375,374,373,372,371,370,369,368,223,222,221,220,219,218,217,216,215,214,213,212,211,210,209,208,207,206,205,204,203,202,201,200,199,198,197,196,195,194,193,192,191,190,189,188,187,186,185,184,183,182,181,180,179,178,177,176,175,174,173,172,171,170,169,168,167,166,165,164,163,162,161,160,271,270,269,268,267,266,265,264,263,262,261,260,259,258,257,256,
367,366,365,364,363,362,361,360,359,358,357,356,355,354,353,352,351,350,349,348,347,346,345,344,343,342,341,340,339,338,337,336,335,334,333,332,331,330,329,328,327,326,325,324,323,322,321,320,319,318,317,316,315,314,313,312,311,310,309,308,307,306,305,304,303,302,301,300,299,298,297,296,295,294,293,292,291,290,289,288,287,286,285,284,283,282,281,280,279,278,277,276,275,274,273,272,
511,510,509,508,507,506,505,504,503,502,501,500,499,498,497,496,495,494,493,492,491,490,489,488,487,486,485,484,483,482,481,480,479,478,477,476,475,474,473,472,471,470,469,468,467,466,465,464,431,430,429,428,427,426,425,424,423,422,421,420,419,418,417,416,415,414,413,412,411,410,409,408,407,406,405,404,403,402,401,400,399,398,397,396,395,394,393,392,391,390,389,388,387,386,385,384,
639,638,637,636,635,634,633,632,631,630,629,628,627,626,625,624,623,622,621,620,619,618,617,616,615,614,613,612,611,610,609,608,463,462,461,460,459,458,457,456,455,454,453,452,451,450,449,448,447,446,445,444,443,442,441,440,439,438,437,436,435,434,433,432,543,542,541,540,539,538,537,536,535,534,533,532,531,530,529,528,527,526,525,524,523,522,521,520,519,518,517,516,515,514,513,512,
767,766,765,764,763,762,761,760,759,758,757,756,755,754,753,752,607,606,605,604,603,602,601,600,599,598,597,596,595,594,593,592,591,590,589,588,587,586,585,584,583,582,581,580,579,578,577,576,575,574,573,572,571,570,569,568,567,566,565,564,563,562,561,560,559,558,557,556,555,554,553,552,551,550,549,548,547,546,545,544,655,654,653,652,651,650,649,648,647,646,645,644,643,642,641,640,
751,750,749,748,747,746,745,744,743,742,741,740,739,738,737,736,735,734,733,732,731,730,729,728,727,726,725,724,723,722,721,720,719,718,717,716,715,714,713,712,711,710,709,708,707,706,705,704,703,702,701,700,699,698,697,696,695,694,693,692,691,690,689,688,687,686,685,684,683,682,681,680,679,678,677,676,675,674,673,672,671,670,669,668,667,666,665,664,663,662,661,660,659,658,657,656};
constexpr int LDS_Q = 131072, LDS_ST = 147456;
__device__ __forceinline__ void mixerB_subunit(const bf16_t* Hq, bf16_t* mix, f32x4* o1g, int head, int qb, float lam, float om_li, const float* subln, LAS unsigned char* lds, int wid, int lane) {
    asm volatile("" : "+v"(lane));
    const int tid = wid * 64 + lane, r32 = lane & 31, hi = lane >> 5;
    __syncthreads();
#pragma unroll
    for (int j = 0; j < 2; ++j) { const int cidx = tid + 512 * j, row = cidx >> 4, ch = cidx & 15;
      const u32x4 v = *(const u32x4*)(Hq + ((size_t)(3 * 6 + head) * SEQ + qb * 64 + row) * HLD + 8 * ch);
      *(LAS u32x4*)(lds + LDS_Q + (row >> 5) * 8192 + off_a(row & 31, ch)) = v; }
    LAS unsigned char* vb = lds + wid * 16384;
    const bf16_t* vcol = Hq + (size_t)(5 * 6 + head) * HSZ;
    const int nt = 2 * qb + 2;
    const unsigned voffA = (unsigned)(((lane >> 2) & 7) * 256 + 16 * (4 * (lane >> 5) + ((lane & 3) ^ ((lane >> 4) & 1))));
    const unsigned voffB = (unsigned)(((lane >> 2) & 7) * 256 + 16 * (4 * (lane >> 5) + ((lane & 3) ^ (2 + ((lane >> 4) & 1)))));
    const char* vbase_u = (const char*)vcol;
#define B_DMA_V(kbase_, buf_, ln_) do { const char* vg_ = vbase_u + (size_t)(kbase_) * 256; _Pragma("unroll") for (int i_ = 0; i_ < 8; ++i_) \
        __builtin_amdgcn_global_load_lds((const unsigned*)((vg_ + (2048 * (i_ >> 1) + 128 * (i_ & 1))) + (((i_ >> 1) & 1) ? voffB : voffA)), (LAS unsigned*)(vb + (buf_) * 8192 + i_ * 1024), 16, 0, 0); } while (0)
    const LAS char *vb0, *vb1; vfrag_bases((const LAS char*)vb, lane, vb0, vb1);
    const LAS unsigned char* qb0 = lds + LDS_Q + 2048 * (r32 >> 3) + 64 * (r32 & 7) + 16 * (hi ^ ((r32 >> 2) & 3));
    const LAS unsigned char* qb1 = lds + LDS_Q + 2048 * (r32 >> 3) + 64 * (r32 & 7) + 16 * ((2 + hi) ^ ((r32 >> 2) & 3));
#pragma unroll 1
    for (int mp = 0; mp < 2; ++mp) {
        __syncthreads();
        f32x16 o[2][4];
#pragma unroll
        for (int h = 0; h < 2; ++h)
#pragma unroll
            for (int d = 0; d < 4; ++d)
#pragma unroll
                for (int r = 0; r < 16; ++r) o[h][d][r] = 0.f;
        float m[2] = {NEGBIG, NEGBIG}, l[2] = {0.f, 0.f};
        const bf16_t* kcol0 = Hq + (size_t)(4 * 6 + head) * HSZ + 64 * mp;
        int cur = 0;
        if (wid < nt) { B_DMA_V(wid * 32, 0, lane); }
        for (int kt = wid; kt < nt; kt += 8) {
            const int kbase = kt * 32;
            const bool has_next = (kt + 8 < nt);
            int ln = lane; asm volatile("" : "+v"(ln));
            const int r32 = ln & 31, hi = ln >> 5;
            bf16x8 kf[4];
            { const bf16_t* krow = kcol0 + 8 * hi + (size_t)(kbase + r32) * HLD;
#pragma unroll
              for (int s = 0; s < 4; ++s) kf[s] = *(const bf16x8*)(krow + 16 * s); }
            if (has_next) { B_DMA_V(kbase + 256, cur ^ 1, ln); }
            __builtin_amdgcn_sched_barrier(0);
#pragma unroll
            for (int h = 0; h < 2; ++h) {
                f32x16 sc;
#pragma unroll
                for (int r = 0; r < 16; ++r) sc[r] = 0.f;
                __builtin_amdgcn_s_setprio(1);
#pragma unroll
                for (int s = 0; s < 4; ++s) { const bf16x8 qf = *(const LAS bf16x8*)(((s & 1) ? qb1 : qb0) + h * 8192 + 512 * (2 * mp + (s >> 1))); sc = __builtin_amdgcn_mfma_f32_32x32x16_bf16(kf[s], qf, sc, 0, 0, 0); }
                __builtin_amdgcn_s_setprio(0);
                if (kt >= 2 * qb) {
                    const int tq = qb * 64 + 32 * h + r32;
#pragma unroll
                    for (int r = 0; r < 16; ++r) { const bool ok = (kbase + crow(r, hi)) <= tq; sc[r] = ok ? sc[r] : NEGBIG; }
                }
                float alpha; bf16x8 p0, p1;
                softmax_tile(sc, m[h], l[h], alpha, p0, p1);
                if (h == 0) { if (has_next) asm volatile("s_waitcnt vmcnt(8)" ::: "memory"); else asm volatile("s_waitcnt vmcnt(0)" ::: "memory"); }
                if (__any(alpha != 1.0f)) {
#pragma unroll
                    for (int d = 0; d < 4; ++d)
#pragma unroll
                        for (int r = 0; r < 16; ++r) o[h][d][r] *= alpha;
                }
                __builtin_amdgcn_s_setprio(1);
#pragma unroll
                for (int d = 0; d < 4; ++d) {
                    const bf16x8 v0 = vfrag(vb0 + cur * 8192, vb1 + cur * 8192, d, 0), v1 = vfrag(vb0 + cur * 8192, vb1 + cur * 8192, d, 1);
                    o[h][d] = __builtin_amdgcn_mfma_f32_32x32x16_bf16(v0, p0, o[h][d], 0, 0, 0);
                    o[h][d] = __builtin_amdgcn_mfma_f32_32x32x16_bf16(v1, p1, o[h][d], 0, 0, 0);
                }
                __builtin_amdgcn_s_setprio(0);
            }
            CFENCE();
            cur ^= 1;
        }
#pragma unroll
        for (int st = 4; st >= 1; st >>= 1) {
            __syncthreads();
            if (wid >= st && wid < 2 * st) {
                LAS f32x4* sl = (LAS f32x4*)(lds + (wid - st) * 32768) + lane;
#pragma unroll
                for (int h = 0; h < 2; ++h)
#pragma unroll
                    for (int d = 0; d < 4; ++d)
#pragma unroll
                        for (int g = 0; g < 4; ++g) sl[(h * 16 + d * 4 + g) * 64] = (f32x4){o[h][d][4 * g], o[h][d][4 * g + 1], o[h][d][4 * g + 2], o[h][d][4 * g + 3]};
                LAS float* sp = (LAS float*)(lds + LDS_ST + (wid - st) * 1024) + lane;
                sp[0] = m[0]; sp[64] = l[0]; sp[128] = m[1]; sp[192] = l[1];
            }
            __syncthreads();
            if (wid < st) {
                const LAS f32x4* sl = (const LAS f32x4*)(lds + wid * 32768) + lane;
                const LAS float* sp = (const LAS float*)(lds + LDS_ST + wid * 1024) + lane;
#pragma unroll
                for (int h = 0; h < 2; ++h) {
                    const float bm = sp[128 * h], bl = sp[128 * h + 64];
                    const float n = fmaxf(m[h], bm);
                    const float fa = __builtin_amdgcn_exp2f(m[h] - n), fb = __builtin_amdgcn_exp2f(bm - n);
                    l[h] = l[h] * fa + bl * fb; m[h] = n;
#pragma unroll
                    for (int d = 0; d < 4; ++d)
#pragma unroll
                        for (int g = 0; g < 4; ++g) {
                            const f32x4 b1 = sl[(h * 16 + d * 4 + g) * 64];
#pragma unroll
                            for (int e = 0; e < 4; ++e) o[h][d][4 * g + e] = o[h][d][4 * g + e] * fa + b1[e] * fb;
                            CFENCE();
                        }
                }
            }
        }
        if (wid == 0) {
            int lf = lane; asm volatile("" : "+v"(lf));
            const int r32 = lf & 31, hi = lf >> 5;
            f32x4* o1p = o1g + lf;
#pragma unroll
            for (int h = 0; h < 2; ++h) {
                if (mp == 0) {
                    const float i1 = 1.0f / l[h];
#pragma unroll
                    for (int d = 0; d < 4; ++d)
#pragma unroll
                        for (int g = 0; g < 4; ++g) { o1p[(h * 16 + d * 4 + g) * 64] = (f32x4){o[h][d][4 * g] * i1, o[h][d][4 * g + 1] * i1, o[h][d][4 * g + 2] * i1, o[h][d][4 * g + 3] * i1}; CFENCE(); }
                } else {
                    const float i2 = lam / l[h];
                    float sq = 0.f;
#pragma unroll
                    for (int d = 0; d < 4; ++d)
#pragma unroll
                        for (int g = 0; g < 4; ++g) { const f32x4 a = o1p[(h * 16 + d * 4 + g) * 64];
#pragma unroll
                            for (int e = 0; e < 4; ++e) { const float v = a[e] - o[h][d][4 * g + e] * i2; o[h][d][4 * g + e] = v; sq += v * v; }
                            CFENCE(); }
                    { auto rr = __builtin_amdgcn_permlane32_swap(__float_as_uint(sq), __float_as_uint(sq), false, false); sq = __uint_as_float(rr[0]) + __uint_as_float(rr[1]); }
                    const float rn = rsqrtf(sq * (1.0f / 128.0f) + EPS) * om_li;
                    bf16_t* orow = mix + (size_t)(qb * 64 + 32 * h + r32) * DM + 768 + head * 128 + 4 * hi;
#pragma unroll
                    for (int d = 0; d < 4; ++d)
#pragma unroll
                        for (int g = 0; g < 4; ++g) {
                            const f32x4 gw = *(const f32x4*)(subln + 32 * d + 8 * g + 4 * hi);
                            u32x2 w; w.x = cvt_pk_bf16(o[h][d][4 * g] * rn * gw[0], o[h][d][4 * g + 1] * rn * gw[1]); w.y = cvt_pk_bf16(o[h][d][4 * g + 2] * rn * gw[2], o[h][d][4 * g + 3] * rn * gw[3]);
                            *(u32x2*)(orow + 32 * d + 8 * g) = w;
                            CFENCE();
                        }
                }
            }
        }
    }
}

__device__ __forceinline__ void sgu_unit(const bf16_t* P, bf16_t* mix, int c, int g, const float* lng, const float* lnb, const float* Wg  , const float* bs  , LAS unsigned char* lds, int wid, int lane) {
    asm volatile("" : "+v"(lane));
    const int tid = wid * 64 + lane, r32 = lane & 31, hi = lane >> 5;
    constexpr int VS = 272;
    const int ib = wid >> 1, eb0 = 2 * (wid & 1), irow = 32 * ib + r32, nks = 2 * (ib + 1);
    f32x4 wpre[8][2];
#pragma unroll
    for (int s = 0; s < 8; ++s) if (s < nks) { const float* wp = Wg + (size_t)irow * 128 + 16 * s + 8 * hi; wpre[s][0] = *(const f32x4*)wp; wpre[s][1] = *(const f32x4*)(wp + 4); }
    __syncthreads();
    {
        const int j = tid >> 2, part = tid & 3;
        const bf16_t* vrow = P + (size_t)(c * 128 + j) * LDP + C_V;
        float s = 0.f, s2 = 0.f;
#pragma unroll 4
        for (int i = 0; i < 16; ++i) { const u32x4 w = *(const u32x4*)(vrow + part * 128 + 8 * i);
#pragma unroll
            for (int e = 0; e < 4; ++e) { const float a = __uint_as_float(w[e] << 16), b = __uint_as_float(w[e] & 0xffff0000u); s += a + b; s2 += a * a + b * b; } }
        s += __shfl_xor(s, 1); s += __shfl_xor(s, 2); s2 += __shfl_xor(s2, 1); s2 += __shfl_xor(s2, 2);
        const float mean = s * (1.0f / 512.0f); const float var = fmaxf(s2 * (1.0f / 512.0f) - mean * mean, 0.f); const float rstd = rsqrtf(var + EPS);
#pragma unroll
        for (int i = 0; i < 4; ++i) { const int e0 = part * 32 + 8 * i; const u32x4 w = *(const u32x4*)(vrow + g * 128 + e0);
#pragma unroll
            for (int e = 0; e < 4; ++e) { const int ch = g * 128 + e0 + 2 * e;
                const float a = (__uint_as_float(w[e] << 16) - mean) * rstd * lng[ch] + lnb[ch];
                const float b = (__uint_as_float(w[e] & 0xffff0000u) - mean) * rstd * lng[ch + 1] + lnb[ch + 1];
                const unsigned pk = cvt_pk_bf16(a, b);
                *(LAS unsigned short*)(lds + (e0 + 2 * e) * VS + 2 * j) = (unsigned short)(pk & 0xffffu);
                *(LAS unsigned short*)(lds + (e0 + 2 * e + 1) * VS + 2 * j) = (unsigned short)(pk >> 16); } }
    }
    __syncthreads();
    f32x16 acc0, acc1;
#pragma unroll
    for (int r = 0; r < 16; ++r) { acc0[r] = 0.f; acc1[r] = 0.f; }
#pragma unroll
    for (int s = 0; s < 8; ++s) if (s < nks) {
        const f32x4 w0 = wpre[s][0], w1 = wpre[s][1];
        const int j0 = 16 * s + 8 * hi;
        float wv[8] = {w0[0], w0[1], w0[2], w0[3], w1[0], w1[1], w1[2], w1[3]};
#pragma unroll
        for (int e = 0; e < 8; ++e) wv[e] = (j0 + e <= irow) ? wv[e] : 0.f;
        u32x4 aw; aw.x = cvt_pk_hw(wv[0], wv[1]); aw.y = cvt_pk_hw(wv[2], wv[3]); aw.z = cvt_pk_hw(wv[4], wv[5]); aw.w = cvt_pk_hw(wv[6], wv[7]);
        const bf16x8 af = __builtin_bit_cast(bf16x8, aw);
        const bf16x8 b0 = *(const LAS bf16x8*)(lds + (32 * eb0 + r32) * VS + 2 * j0);
        const bf16x8 b1 = *(const LAS bf16x8*)(lds + (32 * (eb0 + 1) + r32) * VS + 2 * j0);
        acc0 = __builtin_amdgcn_mfma_f32_32x32x16_bf16(af, b0, acc0, 0, 0, 0);
        acc1 = __builtin_amdgcn_mfma_f32_32x32x16_bf16(af, b1, acc1, 0, 0, 0);
    }
#pragma unroll
    for (int r = 0; r < 16; ++r) {
        const int i = 32 * ib + crow(r, hi); const int tok = c * 128 + i; const float bb = bs[i];
        const bf16_t* up = P + (size_t)tok * LDP + C_U + g * 128; bf16_t* op = mix + (size_t)tok * DM + 1536 + g * 128;
        const int e0 = 32 * eb0 + r32, e1 = e0 + 32;
        const float y0 = bf2f(up[e0]) * (acc0[r] + bb), y1 = bf2f(up[e1]) * (acc1[r] + bb);
        op[e0] = (bf16_t)(cvt_pk_bf16(y0, 0.f) & 0xffffu); op[e1] = (bf16_t)(cvt_pk_bf16(y1, 0.f) & 0xffffu);
    }
}

__device__ __forceinline__ void mixer_phase(const Params& p, unsigned char* ws, int bx, int G, int l, LAS unsigned char* lds, int wid, int lane) {
    const bf16_t* P = (const bf16_t*)(ws + WS_P); const bf16_t* Hq = (const bf16_t*)(ws + WS_HQKV); bf16_t* mix = (bf16_t*)(ws + WS_MIX);
    const float d1 = wave_sum(p.in[3][l * 64 + lane] * p.in[4][l * 64 + lane]);
    const float d2 = wave_sum(p.in[5][l * 64 + lane] * p.in[6][l * 64 + lane]);
    const float li = (l == 0) ? 0.2f : (l == 1) ? 0.35550906759096934f : (l == 2) ? 0.4707130183435842f : 0.5560582041556406f;
    const float lam = __expf(d1) - __expf(d2) + li;
    LAS char* vt = (LAS char*)(lds + wid * 16384);
    for (int u = bx * 8 + wid; u < 1536; u += G * 8) {
        const int head = u / 256, r = u % 256;
#ifndef SKIP_A
#ifdef COPY_A
        { const int tq_ = (r & 15) + 16 * (32 * (r >> 4) + (lane & 31));
          for (int i_ = 0; i_ < 8; ++i_) *(u32x4*)(mix + (size_t)tq_ * DM + head * 128 + 64 * (lane >> 5) + 8 * i_) = *(const u32x4*)(P + (size_t)tq_ * LDP + C_QA + head * 128 + 64 * (lane >> 5) + 8 * i_); }
#else
        mixerA_unit(Hq, mix, head, r & 15, r >> 4, vt, lane);
#endif
#endif
    }
    __syncthreads();
    for (int u = bx; u < 256; u += G) {
        const int c = u >> 2, g = u & 3;
#ifndef SKIP_C
        sgu_unit(P, mix, c, g, p.in[8] + l * 512, p.in[9] + l * 512, p.in[10] + ((size_t)(l * 4 + g) * 128) * 128, p.in[11] + (l * 4 + g) * 128, lds, wid, lane);
#endif
    }
    f32x4* o1g = (f32x4*)(ws + WS_O1) + (size_t)bx * 2048;
#ifndef SKIP_B
    if (G == 256) {
        unsigned* qc = (unsigned*)(ws + WS_BAR) + 3520 + (l * 8 + (bx & 7)) * 16;
        volatile LAS unsigned* qslot = (volatile LAS unsigned*)(lds + LDS_XB + 16);
        for (;;) {
            __syncthreads();
            if (wid == 0 && lane == 0) *qslot = __hip_atomic_fetch_add(qc, 1u, __ATOMIC_RELAXED, __HIP_MEMORY_SCOPE_AGENT);
            __syncthreads();
            const unsigned idx = *qslot;
            if (idx >= 96u) break;
            const int u = b_list[(bx & 7) * 96 + idx];
            mixerB_subunit(Hq, mix, o1g, u >> 7, u & 127, lam, 1.0f - li, p.in[7] + l * 128, lds, wid, lane);
        }
    } else {
        for (int u = bx; u < 768; u += G) mixerB_subunit(Hq, mix, o1g, u >> 7, 127 - (u & 127), lam, 1.0f - li, p.in[7] + l * 128, lds, wid, lane);
    }
#endif
    __syncthreads();
}

__device__ __forceinline__ void convgate_phase(const Params& p, unsigned char* ws, int bx, int G, int l, int tid) {
    const bf16_t* up = (const bf16_t*)(ws + WS_UP); bf16_t* act = (bf16_t*)(ws + WS_ACT);
    const float* cw = p.in[15] + (size_t)l * 3 * UPC; const float* cb = p.in[16] + (size_t)l * UPC;
    const int nth = G * NTHREADS, gt = bx * NTHREADS + tid;
    constexpr int R = 16, NJ = FFN / 8;
    for (int it = gt; it < (SEQ / R) * NJ; it += nth) {
        const int j0 = 8 * (it % NJ), t0 = R * (it / NJ);
        const int gc = 256 * (j0 >> 7) + (j0 & 127);
        float wg[3][8], wv[3][8], bg[8], bv[8];
#pragma unroll
        for (int i = 0; i < 3; ++i) { const f32x4 a = *(const f32x4*)(cw + (size_t)i * UPC + j0), b = *(const f32x4*)(cw + (size_t)i * UPC + j0 + 4);
            const f32x4 c = *(const f32x4*)(cw + (size_t)i * UPC + FFN + j0), d = *(const f32x4*)(cw + (size_t)i * UPC + FFN + j0 + 4);
#pragma unroll
            for (int e = 0; e < 4; ++e) { wg[i][e] = a[e]; wg[i][4 + e] = b[e]; wv[i][e] = c[e]; wv[i][4 + e] = d[e]; } }
        { const f32x4 a = *(const f32x4*)(cb + j0), b = *(const f32x4*)(cb + j0 + 4), c = *(const f32x4*)(cb + FFN + j0), d = *(const f32x4*)(cb + FFN + j0 + 4);
#pragma unroll
          for (int e = 0; e < 4; ++e) { bg[e] = a[e]; bg[4 + e] = b[e]; bv[e] = c[e]; bv[4 + e] = d[e]; } }
        float g2[8], g1[8], v2[8], v1[8];
#define CG_UNPACK(dst, w) do { _Pragma("unroll") for (int e_ = 0; e_ < 4; ++e_) { dst[2 * e_] = __uint_as_float(w[e_] << 16); dst[2 * e_ + 1] = __uint_as_float(w[e_] & 0xffff0000u); } } while (0)
        if (t0 > 0) {
            const u32x4 a = *(const u32x4*)(up + (size_t)(t0 - 2) * UPC + gc), b = *(const u32x4*)(up + (size_t)(t0 - 2) * UPC + gc + 128);
            const u32x4 c = *(const u32x4*)(up + (size_t)(t0 - 1) * UPC + gc), d = *(const u32x4*)(up + (size_t)(t0 - 1) * UPC + gc + 128);
            CG_UNPACK(g2, a); CG_UNPACK(v2, b); CG_UNPACK(g1, c); CG_UNPACK(v1, d);
        } else {
#pragma unroll
            for (int e = 0; e < 8; ++e) { g2[e] = 0.f; g1[e] = 0.f; v2[e] = 0.f; v1[e] = 0.f; }
        }
#pragma unroll 1
        for (int rb = 0; rb < R; rb += 4) {
            u32x4 rg[4], rv[4];
#pragma unroll
            for (int r = 0; r < 4; ++r) { rg[r] = *(const u32x4*)(up + (size_t)(t0 + rb + r) * UPC + gc); rv[r] = *(const u32x4*)(up + (size_t)(t0 + rb + r) * UPC + gc + 128); }
#pragma unroll
            for (int r = 0; r < 4; ++r) {
                float g0[8], v0[8]; CG_UNPACK(g0, rg[r]); CG_UNPACK(v0, rv[r]);
                float o[8];
#pragma unroll
                for (int e = 0; e < 8; ++e) {
                    const float cg_ = bg[e] + wg[0][e] * g2[e] + wg[1][e] * g1[e] + wg[2][e] * g0[e];
                    const float cv_ = bv[e] + wv[0][e] * v2[e] + wv[1][e] * v1[e] + wv[2][e] * v0[e];
                    o[e] = cg_ / (1.0f + __expf(-cg_)) * cv_;
                    g2[e] = g1[e]; g1[e] = g0[e]; v2[e] = v1[e]; v1[e] = v0[e];
                }
                u32x4 w; w.x = cvt_pk_bf16(o[0], o[1]); w.y = cvt_pk_bf16(o[2], o[3]); w.z = cvt_pk_bf16(o[4], o[5]); w.w = cvt_pk_bf16(o[6], o[7]);
                *(u32x4*)(act + (size_t)(t0 + rb + r) * FFN + j0) = w;
            }
        }
#undef CG_UNPACK
    }
}

__device__ __forceinline__ void final_phase(const Params& p, unsigned char* ws, int gw, int NGW, int lane) {
    const float* ss = (const float*)(ws + WS_SS) + (size_t)8 * SEQ * 32; const f32x4* gf = (const f32x4*)p.in[18] + lane;
    for (int m = gw; m < SEQ; m += NGW) {
        const float rstd = rsqrtf(ss_sum(ss + (size_t)m * 32) * (1.0f / DM) + EPS);
        f32x4* orow = (f32x4*)(p.out + (size_t)m * DM) + lane;
#pragma unroll
        for (int j = 0; j < 8; ++j) { f32x4 v = orow[64 * j]; v = v * rstd * gf[64 * j]; orow[64 * j] = v; }
    }
}

constexpr int N_PHASES = 26;
__global__ void __launch_bounds__(NTHREADS, 2) fwd_kernel(Params p_arg) {
    extern __shared__ __attribute__((aligned(16))) unsigned char lds_raw[];
    LAS unsigned char* lds = (LAS unsigned char*)lds_raw;
    const int ph_lo = p_arg.ph_lo, ph_hi = p_arg.ph_hi;
    volatile LAS unsigned* xst = (volatile LAS unsigned*)(lds + LDS_XB);
    if (threadIdx.x == 0) { xst[0] = 0u; xst[1] = 0u; }
    __syncthreads();
    const XcdBarrier xbar = xcd_barrier_post((unsigned*)(p_arg.ws + WS_BAR), xst, (int)threadIdx.x);
    for (int ph = ph_lo; ph < ph_hi; ++ph) {
        const __attribute__((address_space(4))) Params* pp = (const __attribute__((address_space(4))) Params*)__builtin_amdgcn_kernarg_segment_ptr(); asm volatile("" : "+s"(pp));
        Params p;
#pragma unroll
        for (int i_ = 0; i_ < 19; ++i_) p.in[i_] = (const float*)(const __attribute__((address_space(1))) float*)(pp->in[i_]);
        p.out = (float*)(__attribute__((address_space(1))) float*)(pp->out); p.ws = (unsigned char*)(__attribute__((address_space(1))) unsigned char*)(pp->ws); p.ph_lo = ph_lo; p.ph_hi = ph_hi;
        int tid = threadIdx.x; asm volatile("" : "+v"(tid));
        int bx = blockIdx.x, G = gridDim.x; asm volatile("" : "+s"(bx), "+s"(G));
        unsigned char* ws = p.ws;
        bf16_t* xb = (bf16_t*)(ws + WS_XB0 + XB_PAD); float* ss = (float*)(ws + WS_SS);
        const int lane = tid & 63, wid = __builtin_amdgcn_readfirstlane(tid >> 6);
        const int gw = bx * 8 + wid, NGW = G * 8;
#ifndef SKIP_PRO
        if (ph == 0) { prologue(p, ws, lds, gw, NGW, wid, lane);
#ifdef REP_PRO
            prologue(p, ws, lds, gw, NGW, wid, lane);
#endif
        }
#else
        if (ph == 0) {}
#endif
        else if (ph == 25) final_phase(p, ws, gw, NGW, lane);
        else {
            const int l = (ph - 1) / 6, k = (ph - 1) % 6;
            pg8::StaticOrder S;
#ifndef ONLY_K
#define ONLY_K -1
#endif
            if (k == 0 && (ONLY_K < 0 || ONLY_K == 0)) {
                pg8::Gemm g{xb, (const bf16_t*)(ws + WS_WIN + l * SZ_WIN), SEQ / 256, INC / 256, DM, 256}; S.init(g.nM, g.nN, G, bx);
                EpiInProj E{(bf16_t*)(ws + WS_P), (bf16_t*)(ws + WS_HQKV), ss + (size_t)(2 * l) * SEQ * 32, (const f32x2*)(ws + WS_TABA), (const f32x2*)(ws + WS_TABB)};
                pg8::gemm_phase<EpiInProj>(lds, g, S, E, tid);
            } else if (k == 1) {
                mixer_phase(p, ws, bx, G, l, lds, wid, lane);
#ifdef REP_MIX
                mixer_phase(p, ws, bx, G, l, lds, wid, lane);
#endif
            } else if (k == 2 && (ONLY_K < 0 || ONLY_K == 2)) {
                pg8::Gemm g{(const bf16_t*)(ws + WS_MIX), (const bf16_t*)(ws + WS_WOUT + l * SZ_WOUT), SEQ / 256, DM / 256, DM, 256}; S.init(g.nM, g.nN, G, bx);
                EpiResid E{p.out, xb, ss + (size_t)(2 * l + 1) * SEQ * 32};
                pg8::gemm_phase<EpiResid>(lds, g, S, E, tid);
            } else if (k == 3 && (ONLY_K < 0 || ONLY_K == 3)) {
                pg8::Gemm g{xb - 2 * DM, (const bf16_t*)(ws + WS_WUP + l * SZ_WUP), 33, UPC / 256, DM, 254}; S.init(g.nM, g.nN, G, bx);
                EpiUpConv E{(bf16_t*)(ws + WS_ACT), ss + (size_t)(2 * l + 1) * SEQ * 32, p.in[15] + (size_t)l * 3 * UPC, p.in[16] + (size_t)l * UPC};
                pg8::gemm_phase<EpiUpConv>(lds, g, S, E, tid);
            } else if (k == 4 && (ONLY_K < 0 || ONLY_K == 4)) {
                continue;
            } else if (ONLY_K < 0 || ONLY_K == 5) {
                pg8::Gemm g{(const bf16_t*)(ws + WS_ACT), (const bf16_t*)(ws + WS_WDN + l * SZ_WDN), SEQ / 256, DM / 256, FFN, 256}; S.init(g.nM, g.nN, G, bx);
                EpiResid E{p.out, xb, ss + (size_t)(2 * l + 2) * SEQ * 32};
                pg8::gemm_phase<EpiResid>(lds, g, S, E, tid);
            }
        }
        if (ph + 1 < ph_hi) { if (ph_lo > 0) cg::this_grid().sync(); else xcd_barrier(xbar, tid); }
    }
}

#ifndef MK_PER_PHASE_LAUNCH
#define MK_PER_PHASE_LAUNCH 0
#endif
extern "C" void kernel_launch(void* const* d_in, const int* in_sizes, int n_in, void* d_out, int out_size, void* d_ws, size_t ws_size, hipStream_t stream) {
    static int grid = 0;
    if (grid == 0) {
        int dev = 0, cus = 0, per_cu = 0;
        hipGetDevice(&dev);
        hipDeviceGetAttribute(&cus, hipDeviceAttributeMultiprocessorCount, dev);
        hipFuncSetAttribute((const void*)fwd_kernel, hipFuncAttributeMaxDynamicSharedMemorySize, LDS_BYTES);
        hipOccupancyMaxActiveBlocksPerMultiprocessor(&per_cu, (const void*)fwd_kernel, NTHREADS, LDS_BYTES);
        if (per_cu < 1) { fprintf(stderr, "occupancy query says %d blocks/CU\n", per_cu); per_cu = 1; }
        grid = cus * 1;
        if (ws_size < WS_END) { fprintf(stderr, "workspace too small: %zu < %zu\n", ws_size, (size_t)WS_END); grid = -1; }
    }
    if (grid < 0) return;
    Params p{};
    for (int i = 0; i < 19; ++i) p.in[i] = (const float*)d_in[i];
    p.out = (float*)d_out; p.ws = (unsigned char*)d_ws;
#if MK_PER_PHASE_LAUNCH
    for (int ph = 0; ph < N_PHASES; ++ph) {
        p.ph_lo = ph; p.ph_hi = ph + 1;
        hipLaunchKernelGGL(fwd_kernel, dim3(grid), dim3(NTHREADS), LDS_BYTES, stream, p);
    }
#else
    p.ph_lo = 0; p.ph_hi = N_PHASES;
    hipMemsetAsync((char*)d_ws + WS_BAR, 0, 16384, stream);
    void* args[] = {&p};
    hipError_t e = hipLaunchCooperativeKernel((const void*)fwd_kernel, dim3(grid), dim3(NTHREADS), args, LDS_BYTES, stream);
    if (e != hipSuccess) fprintf(stderr, "cooperative launch failed: %s (grid %d)\n", hipGetErrorString(e), grid);
#endif
}
```

```cpp
#include <hip/hip_runtime.h>
#include <hip/hip_cooperative_groups.h>
#include <cstdio>
#include <cstdint>
#define USE_TR 1


namespace cg = cooperative_groups;

#define LAS __attribute__((address_space(3)))
typedef unsigned short bf16_t;
typedef short bf16x8 __attribute__((ext_vector_type(8)));
typedef float f32x4 __attribute__((ext_vector_type(4)));
typedef float f32x2 __attribute__((ext_vector_type(2)));
typedef float f32x16 __attribute__((ext_vector_type(16)));
typedef unsigned u32x4 __attribute__((ext_vector_type(4)));
typedef unsigned u32x2 __attribute__((ext_vector_type(2)));
typedef short s16x4 __attribute__((ext_vector_type(4)));

constexpr int SEQ = 8192, DM = 2048, DEPTH = 4, INC = 5632, FFN = 5632, UPC = 11264;
constexpr int LDP = INC;
constexpr int C_QA = 0, C_KA = 768, C_VA = 1536, C_QB = 2304, C_KB = 3072, C_VB = 3840, C_U = 4608, C_V = 5120;
constexpr int HLD = 128;
constexpr size_t HSZ = (size_t)SEQ * HLD;
constexpr float EPS = 1e-6f;
constexpr float SCALE_A = 0.12751743082459868f;
constexpr float SCALE_B = 0.18033688011112042f;
constexpr float NEGBIG = -1e30f;

constexpr size_t MiB = 1u << 20;
constexpr size_t SZ_WIN = (size_t)INC * DM * 2, SZ_WOUT = (size_t)DM * DM * 2, SZ_WUP = (size_t)UPC * DM * 2, SZ_WDN = (size_t)DM * FFN * 2;
constexpr size_t WS_WIN = 0;
constexpr size_t WS_WOUT = WS_WIN + 4 * SZ_WIN;
constexpr size_t WS_WUP = WS_WOUT + 4 * SZ_WOUT;
constexpr size_t WS_WDN = WS_WUP + 4 * SZ_WUP;
constexpr size_t WS_XB0 = WS_WDN + 4 * SZ_WDN;
constexpr size_t XB_PAD = (size_t)256 * DM * 2;
constexpr size_t WS_P = WS_XB0 + (size_t)(SEQ + 512) * DM * 2;
constexpr size_t WS_MIX = WS_P + (size_t)SEQ * INC * 2;
constexpr size_t WS_UP = WS_MIX + (size_t)SEQ * DM * 2;
constexpr size_t WS_ACT = WS_UP + (size_t)SEQ * UPC * 2;
constexpr size_t WS_SS = WS_ACT + (size_t)SEQ * FFN * 2;
constexpr size_t WS_TABA = WS_SS + (size_t)9 * SEQ * 32 * 4;
constexpr size_t WS_TABB = WS_TABA + (size_t)SEQ * 16 * 8;
constexpr size_t WS_O1 = WS_TABB + (size_t)SEQ * 8 * 8;
constexpr size_t WS_BAR = WS_O1 + (size_t)1024 * 32768;
constexpr size_t WS_HQKV = WS_BAR + 16384;
constexpr size_t WS_END = WS_HQKV + (size_t)36 * SEQ * 128 * 2;

constexpr int LDS_BYTES = 160832;
constexpr int NTHREADS = 512;
constexpr int LDS_RSTD = 159744, LDS_XB = 160768;

namespace pg8 {
constexpr int BM = 256, BK = 64, HALF = 128, HTB = HALF * BK * 2, STAGE_BYTES = 8 * HTB, NXCD = 8, WGM = 8;
__host__ __device__ __forceinline__ int lds_byte(int r, int c) { const int st = (r >> 4) * 2 + (c >> 5), rr = r & 15, cc = c & 31, ob = rr * 64 + cc * 2; return st * 1024 + (ob ^ (((ob >> 9) & 1) << 5)); }
__host__ __device__ __forceinline__ void stage_rc(int b, int& R, int& C) { const int st = b / 1024, sb = b % 1024, swz = sb ^ (((sb >> 9) & 1) << 5); R = (st >> 1) * 16 + swz / 64; C = (st & 1) * 32 + (swz % 64) / 2; }
__host__ __device__ __forceinline__ int perm32(int rho) { const int n = rho >> 4, i = rho & 15; return 8 * (i >> 2) + 4 * n + (i & 3); }

struct Unit { int pm, pn; };
struct Gemm { const bf16_t* A; const bf16_t* Bt; int nM, nN, K; int arows; };

struct StaticOrder {
    int nM, nN, nwg, G, c;
    __device__ void init(int nM_, int nN_, int G_, int c_) { nM = nM_; nN = nN_; nwg = nM * nN; G = G_; c = c_; }
    __device__ bool next(int i, Unit& u) const {
        const long L = (long)i * G + c; if (L >= nwg) return false;
        int wgid = (int)L; { const int q = nwg / NXCD, r = nwg % NXCD, xcd = wgid % NXCD, off = wgid / NXCD; wgid = (xcd < r ? xcd * (q + 1) : r * (q + 1) + (xcd - r) * q) + off; }
        const int nig = WGM * nN, gid = wgid / nig, fm = gid * WGM, gsz = (nM - fm) < WGM ? (nM - fm) : WGM;
        u.pm = fm + ((wgid % nig) % gsz); u.pn = (wgid % nig) / gsz; return true;
    }
};

typedef __bf16 bf16x2_hw __attribute__((ext_vector_type(2)));
typedef float f32x2_hw __attribute__((ext_vector_type(2)));
__device__ __forceinline__ unsigned cvt_pk_hw(float lo, float hi) { f32x2_hw v = {lo, hi}; bf16x2_hw b = __builtin_convertvector(v, bf16x2_hw); return __builtin_bit_cast(unsigned, b); }
__device__ __forceinline__ unsigned cvt_pk_bf16(float lo, float hi) { unsigned r; asm volatile("v_cvt_pk_bf16_f32 %0, %1, %2" : "=v"(r) : "v"(lo), "v"(hi)); return r; }
__device__ __forceinline__ f32x2 gelu_pk(f32x2 v) {
    const f32x2 av = __builtin_elementwise_abs(v), d = av * 0.2316418882f + 1.0f;
    f32x2 t; t.x = __builtin_amdgcn_rcpf(d.x); t.y = __builtin_amdgcn_rcpf(d.y);
    f32x2 q = t * 0.5307027145f + (-0.7265760135f); q = q * t + 0.7107068705f; q = q * t + (-0.142248368f); q = q * t + 0.127414796f; q = q * t;
    const f32x2 s = (v * v) * (-0.72134752044f);
    f32x2 e; e.x = __builtin_amdgcn_exp2f(s.x); e.y = __builtin_amdgcn_exp2f(s.y);
    const f32x2 m = v * (q * e), r = v - m;
    f32x2 o; o.x = v.x < 0.f ? m.x : r.x; o.y = v.y < 0.f ? m.y : r.y; return o;
}

template <class Epi, bool ALIGN_EPI = true>
__device__ __forceinline__ void gemm_phase(LAS unsigned char* lds, const Gemm g, const StaticOrder& S, const Epi& E, const int tid) {
    const int wid = __builtin_amdgcn_readfirstlane(tid >> 6), lane = tid & 63, wr = wid >> 2, wc = wid & 3, fr = lane & 15, fq = lane >> 4;
    const int K = g.K, nt = K / BK;
    unsigned voffA[2], voffB[2];
#pragma unroll
    for (int i = 0; i < 2; ++i) { int R, C; stage_rc(tid * 16 + i * 8192, R, C); const int Rb = Epi::PERM ? ((R & ~31) + perm32(R & 31)) : R;
        voffA[i] = (unsigned)(R * K + C) * 2u; voffB[i] = (unsigned)(Rb * K + C) * 2u; }
    const size_t kstep = (size_t)(BK * 2);
    const size_t hstep = (size_t)HALF * K * 2;
    const size_t tstepB = 2 * hstep;
    const size_t tstepA = (size_t)g.arows * K * 2;
    const unsigned ldsw = (unsigned)wid * 1024u;
    const int aoff = lds_byte(wr * 64 + fr, fq * 8), boff = lds_byte(wc * 32 + fr, fq * 8);
#define PG8_SA(b, h) (((b) * 2 + (h)) * HTB)
#define PG8_SB(b, h) ((4 + (b) * 2 + (h)) * HTB)
#define PG8_STAGE(bufoff, gbase, voff) do { _Pragma("unroll") for (int _i = 0; _i < 2; ++_i) \
        __builtin_amdgcn_global_load_lds((const unsigned*)((const char*)(gbase) + (voff)[_i]), (LAS unsigned*)(lds + (bufoff) + ldsw + _i * 8192), 16, 0, 0); } while (0)
#define PG8_LDA(dst, b, h) do { _Pragma("unroll") for (int m = 0; m < 4; ++m) _Pragma("unroll") for (int k = 0; k < 2; ++k) dst[m][k] = *(const LAS bf16x8*)(lds + PG8_SA(b, h) + aoff + m * 2048 + k * 1024); } while (0)
#define PG8_LDB(dst, b, h) do { _Pragma("unroll") for (int n = 0; n < 2; ++n) _Pragma("unroll") for (int k = 0; k < 2; ++k) dst[n][k] = *(const LAS bf16x8*)(lds + PG8_SB(b, h) + boff + n * 2048 + k * 1024); } while (0)
#define PG8_MMA(ai, bj, At, Bt) do { __builtin_amdgcn_s_setprio(1); _Pragma("unroll") for (int m = 0; m < 4; ++m) _Pragma("unroll") for (int n = 0; n < 2; ++n) _Pragma("unroll") for (int k = 0; k < 2; ++k) \
        acc[ai][bj][m][n] = __builtin_amdgcn_mfma_f32_16x16x32_bf16(Bt[n][k], At[m][k], acc[ai][bj][m][n], 0, 0, 0); __builtin_amdgcn_s_setprio(0); } while (0)
#define PG8_WAIT_V(n) asm volatile("s_waitcnt vmcnt(" #n ")" ::: "memory")
#define PG8_WAIT_L(n) asm volatile("s_waitcnt lgkmcnt(" #n ")" ::: "memory")
#define PG8_BAR __builtin_amdgcn_s_barrier()
#define PG8_SCHED __builtin_amdgcn_sched_barrier(0)
    Unit cur, nxt; int ui = 0;
    if (!S.next(0, cur)) return;
    f32x4 acc[2][2][4][2];
#pragma unroll
    for (int a = 0; a < 2; ++a)
#pragma unroll
        for (int b = 0; b < 2; ++b)
#pragma unroll
            for (int m = 0; m < 4; ++m)
#pragma unroll
                for (int n = 0; n < 2; ++n) acc[a][b][m][n] = (f32x4){0.f, 0.f, 0.f, 0.f};
    bf16x8 At[4][2], B0[2][2], B1[2][2];
    const char* cA = (const char*)g.A + (size_t)cur.pm * tstepA; const char* cB = (const char*)g.Bt + (size_t)cur.pn * tstepB;
    PG8_STAGE(PG8_SB(0, 0), cB, voffB); PG8_STAGE(PG8_SB(0, 1), cB + hstep, voffB); PG8_STAGE(PG8_SA(0, 0), cA, voffA); PG8_STAGE(PG8_SA(0, 1), cA + hstep, voffA);
    if (wr == 1) PG8_BAR;
    PG8_WAIT_V(2); PG8_BAR;
    PG8_STAGE(PG8_SB(1, 0), cB + kstep, voffB); PG8_STAGE(PG8_SA(1, 0), cA + kstep, voffA); PG8_STAGE(PG8_SB(1, 1), cB + hstep + kstep, voffB);
    PG8_WAIT_V(6); PG8_BAR;
    for (;;) {
        const bool has_next = S.next(ui + 1, nxt);
        const char* nA = has_next ? (const char*)g.A + (size_t)nxt.pm * tstepA : cA; const char* nB = has_next ? (const char*)g.Bt + (size_t)nxt.pn * tstepB : cB;
        for (int t = 0; t < nt; t += 2) {
            const bool last = (t == nt - 2);
            const char* a1 = cA + (size_t)(t + 1) * kstep;
            const char* a2 = last ? nA : cA + (size_t)(t + 2) * kstep; const char* b2 = last ? nB : cB + (size_t)(t + 2) * kstep;
            const char* a3 = a2 + kstep; const char* b3 = b2 + kstep;
            PG8_LDB(B0, 0, 0); PG8_LDB(B1, 0, 1); PG8_SCHED; PG8_LDA(At, 0, 0); PG8_STAGE(PG8_SA(1, 1), a1 + hstep, voffA);
            PG8_WAIT_V(8); PG8_WAIT_L(0); PG8_BAR; PG8_MMA(0, 0, At, B0); PG8_MMA(0, 1, At, B1); PG8_BAR; PG8_SCHED;
            PG8_LDA(At, 0, 1); PG8_STAGE(PG8_SB(0, 0), b2, voffB); PG8_STAGE(PG8_SB(0, 1), b2 + hstep, voffB); PG8_STAGE(PG8_SA(0, 0), a2, voffA);
            PG8_WAIT_V(8); PG8_WAIT_L(0); PG8_BAR; PG8_MMA(1, 0, At, B0); PG8_MMA(1, 1, At, B1); PG8_BAR; PG8_SCHED;
            PG8_LDB(B0, 1, 0); PG8_LDB(B1, 1, 1); PG8_SCHED; PG8_LDA(At, 1, 0); PG8_STAGE(PG8_SA(0, 1), a2 + hstep, voffA);
            PG8_WAIT_V(8); PG8_WAIT_L(0); PG8_BAR; PG8_MMA(0, 0, At, B0); PG8_MMA(0, 1, At, B1); PG8_BAR; PG8_SCHED;
            PG8_LDA(At, 1, 1); PG8_STAGE(PG8_SB(1, 0), b3, voffB); PG8_STAGE(PG8_SB(1, 1), b3 + hstep, voffB); PG8_STAGE(PG8_SA(1, 0), a3, voffA);
            PG8_WAIT_V(8); PG8_WAIT_L(0); PG8_BAR; PG8_MMA(1, 0, At, B0); PG8_MMA(1, 1, At, B1); PG8_BAR; PG8_SCHED;
        }
        if constexpr (ALIGN_EPI) { if (wr == 0) PG8_BAR; }
        E(acc, cur, wr, wc, fr, fq);
        if (!has_next) break;
#pragma unroll
        for (int a = 0; a < 2; ++a)
#pragma unroll
            for (int b = 0; b < 2; ++b)
#pragma unroll
                for (int m = 0; m < 4; ++m)
#pragma unroll
                    for (int n = 0; n < 2; ++n) acc[a][b][m][n] = (f32x4){0.f, 0.f, 0.f, 0.f};
        cur = nxt; cA = nA; cB = nB; ++ui;
        if constexpr (ALIGN_EPI) { if (wr == 1) PG8_BAR; }
    }
    PG8_WAIT_V(0);
    if constexpr (!ALIGN_EPI) { if (wr == 0) PG8_BAR; }
    PG8_BAR;
#undef PG8_SA
#undef PG8_SB
#undef PG8_STAGE
#undef PG8_LDA
#undef PG8_LDB
#undef PG8_MMA
#undef PG8_WAIT_V
#undef PG8_WAIT_L
#undef PG8_BAR
#undef PG8_SCHED
}
}
using pg8::cvt_pk_bf16; using pg8::cvt_pk_hw;
#define CFENCE() asm volatile("" ::: "memory")
__device__ __forceinline__ float ss_sum(const float* ssrow) {
    const f32x4* q = (const f32x4*)ssrow; float s = 0.f;
#pragma unroll
    for (int i = 0; i < 8; ++i) { const f32x4 v = q[i]; s += (v[0] + v[1]) + (v[2] + v[3]); }
    return s;
}

__device__ __forceinline__ void rstd_table(const float* ss, int row0, float scale, int wr, int wc, int fr, int fq) {
    extern __shared__ __attribute__((aligned(16))) unsigned char lds_raw_[];
    LAS float* tab = (LAS float*)((LAS unsigned char*)lds_raw_ + LDS_RSTD);
    const int t = (wr * 4 + wc) * 64 + fq * 16 + fr;
    const f32x4* q = (const f32x4*)(ss + (size_t)(row0 + (t >> 1)) * 32) + 4 * (t & 1);
    const f32x4 a = q[0], b = q[1], c = q[2], d = q[3];
    float s = ((a[0] + a[1]) + (a[2] + a[3])) + ((b[0] + b[1]) + (b[2] + b[3])) + ((c[0] + c[1]) + (c[2] + c[3])) + ((d[0] + d[1]) + (d[2] + d[3]));
    const float o = __shfl_xor(s, 1);
    s = (t & 1) ? (o + s) : (s + o);
    if ((t & 1) == 0) tab[t >> 1] = rsqrtf(s * (1.0f / DM) + EPS) * scale;
    asm volatile("s_waitcnt lgkmcnt(0)" ::: "memory"); __builtin_amdgcn_s_barrier(); asm volatile("" ::: "memory");
}
__device__ __forceinline__ float rstd_get(int rloc) {
    extern __shared__ __attribute__((aligned(16))) unsigned char lds_raw_[];
    return ((const LAS float*)((LAS unsigned char*)lds_raw_ + LDS_RSTD))[rloc];
}
struct EpiInProj {
    static constexpr bool PERM = true;
    bf16_t* P; bf16_t* Hq; const float* ss; const f32x2* tabA; const f32x2* tabB;
    __device__ __forceinline__ void operator()(const f32x4 (&acc)[2][2][4][2], const pg8::Unit& u, int wr, int wc, int fr, int fq) const {
        const int row0 = u.pm * 256 + wr * 64 + fr, col0 = u.pn * 256 + wc * 32 + 8 * fq;
        const int ty = u.pn / 3;
        const bool ropeA = (ty == 0 || ty == 1) && wc == 0;
        const bool ropeB = (ty == 3 || ty == 4) && ((wc & 1) == 0);
        const float sc = (ty == 0) ? SCALE_A : (ty == 3) ? SCALE_B : 1.0f;
        rstd_table(ss, u.pm * 256, sc, wr, wc, fr, fq);
#pragma unroll
        for (int ai = 0; ai < 2; ++ai) {
#pragma unroll
          for (int mh = 0; mh < 2; ++mh) {
            f32x4 tb[4][4];
            if (ropeA || ropeB) {
#pragma unroll
                for (int m = 2 * mh; m < 2 * mh + 2; ++m) { const int row = row0 + ai * 128 + m * 16;
                    const f32x4* tp = ropeA ? (const f32x4*)(tabA + (size_t)row * 16 + 8 * (fq & 1)) : (const f32x4*)(tabB + (size_t)row * 8);
#pragma unroll
                    for (int j = 0; j < 4; ++j) tb[m][j] = tp[j]; }
            }
            CFENCE();
#pragma unroll
            for (int m = 2 * mh; m < 2 * mh + 2; ++m) {
                const int row = row0 + ai * 128 + m * 16;
                const float rstd = rstd_get(wr * 64 + fr + ai * 128 + m * 16);
                bf16_t* rowp = (ty < 6) ? Hq + ((size_t)(ty * 6 + (u.pn % 3) * 2) * SEQ + row) * HLD + wc * 32 + 8 * fq : P + (size_t)row * LDP + col0;
                const size_t bjstep = (ty < 6) ? HSZ : (size_t)128;
#pragma unroll
                for (int bj = 0; bj < 2; ++bj) {
                    float v[8];
#pragma unroll
                    for (int e = 0; e < 4; ++e) { v[e] = acc[ai][bj][m][0][e] * rstd; v[4 + e] = acc[ai][bj][m][1][e] * rstd; }
                    if (ropeA) {
                        const float sg = (fq < 2) ? -1.f : 1.f;
#pragma unroll
                        for (int e = 0; e < 8; ++e) { const float pv = __shfl_xor(v[e], 32); const float cx = tb[m][e >> 1][2 * (e & 1)], sy = tb[m][e >> 1][2 * (e & 1) + 1]; v[e] = v[e] * cx + sg * pv * sy; }
                    } else if (ropeB) {
                        const float sg = (fq == 0) ? -1.f : 1.f;
#pragma unroll
                        for (int e = 0; e < 8; ++e) { const float pv = __shfl_xor(v[e], 16); const float cx = tb[m][e >> 1][2 * (e & 1)], sy = tb[m][e >> 1][2 * (e & 1) + 1]; const float r = v[e] * cx + sg * pv * sy; v[e] = (fq < 2) ? r : v[e]; }
                    } else if (ty >= 6) {
#pragma unroll
                        for (int e = 0; e < 8; e += 2) { const f32x2 gg = pg8::gelu_pk((f32x2){v[e], v[e + 1]}); v[e] = gg.x; v[e + 1] = gg.y; }
                    }
                    u32x4 w; w.x = cvt_pk_bf16(v[0], v[1]); w.y = cvt_pk_bf16(v[2], v[3]); w.z = cvt_pk_bf16(v[4], v[5]); w.w = cvt_pk_bf16(v[6], v[7]);
                    *(u32x4*)(rowp + bj * bjstep) = w;
                }
                CFENCE();
            }
          }
        }
    }
};
struct EpiResid {
    static constexpr bool PERM = true;
    float* x; bf16_t* xb; float* ssn;
    __device__ __forceinline__ void operator()(const f32x4 (&acc)[2][2][4][2], const pg8::Unit& u, int wr, int wc, int fr, int fq) const {
        const int row0 = u.pm * 256 + wr * 64 + fr, col0 = u.pn * 256 + wc * 32 + 8 * fq;
#pragma unroll
        for (int ai = 0; ai < 2; ++ai) {
            f32x4 pre[4][2][2];
#pragma unroll
            for (int m = 0; m < 4; ++m) { const float* xr = x + (size_t)(row0 + ai * 128 + m * 16) * DM + col0;
#pragma unroll
                for (int bj = 0; bj < 2; ++bj) { pre[m][bj][0] = *(const f32x4*)(xr + bj * 128); pre[m][bj][1] = *(const f32x4*)(xr + bj * 128 + 4); } }
            CFENCE();
#pragma unroll
            for (int m = 0; m < 4; ++m) {
                const int row = row0 + ai * 128 + m * 16;
                float* xr = x + (size_t)row * DM + col0; bf16_t* br = xb + (size_t)row * DM + col0;
                float s = 0.f;
#pragma unroll
                for (int bj = 0; bj < 2; ++bj) {
                    const f32x4 a = pre[m][bj][0] + acc[ai][bj][m][0], b = pre[m][bj][1] + acc[ai][bj][m][1];
                    *(f32x4*)(xr + bj * 128) = a; *(f32x4*)(xr + bj * 128 + 4) = b;
                    s += (a[0] * a[0] + a[1] * a[1]) + (a[2] * a[2] + a[3] * a[3]) + (b[0] * b[0] + b[1] * b[1]) + (b[2] * b[2] + b[3] * b[3]);
                    u32x4 w; w.x = cvt_pk_bf16(a[0], a[1]); w.y = cvt_pk_bf16(a[2], a[3]); w.z = cvt_pk_bf16(b[0], b[1]); w.w = cvt_pk_bf16(b[2], b[3]);
                    *(u32x4*)(br + bj * 128) = w;
                }
                s += __shfl_xor(s, 16); s += __shfl_xor(s, 32);
                if (fq == 0) ssn[(size_t)row * 32 + u.pn * 4 + wc] = s;
            }
            CFENCE();
        }
    }
};
struct EpiUpRaw {
    static constexpr bool PERM = true;
    bf16_t* O; const float* ss;
    __device__ __forceinline__ void operator()(const f32x4 (&acc)[2][2][4][2], const pg8::Unit& u, int wr, int wc, int fr, int fq) const {
        const int row0 = u.pm * 256 + wr * 64 + fr, col0 = u.pn * 256 + wc * 32 + 8 * fq;
        rstd_table(ss, u.pm * 256, 1.0f, wr, wc, fr, fq);
#pragma unroll
        for (int ai = 0; ai < 2; ++ai)
#pragma unroll
            for (int m = 0; m < 4; ++m) {
                const int row = row0 + ai * 128 + m * 16;
                const float rstd = rstd_get(wr * 64 + fr + ai * 128 + m * 16);
                bf16_t* rowp = O + (size_t)row * UPC + col0;
#pragma unroll
                for (int bj = 0; bj < 2; ++bj) {
                    const f32x4 v0 = acc[ai][bj][m][0] * rstd, v1 = acc[ai][bj][m][1] * rstd;
                    u32x4 w; w.x = cvt_pk_bf16(v0[0], v0[1]); w.y = cvt_pk_bf16(v0[2], v0[3]); w.z = cvt_pk_bf16(v1[0], v1[1]); w.w = cvt_pk_bf16(v1[2], v1[3]);
                    *(u32x4*)(rowp + bj * 128) = w;
                }
                CFENCE();
            }
    }
};

constexpr int LDS_XCH = 131072;
__device__ __forceinline__ float dpp_ror1(float v) { return __int_as_float(__builtin_amdgcn_update_dpp(0, __float_as_int(v), 0x121, 0xF, 0xF, true)); }
__device__ __forceinline__ float dpp_ror2(float v) { return __int_as_float(__builtin_amdgcn_update_dpp(0, __float_as_int(v), 0x122, 0xF, 0xF, true)); }
struct EpiUpConv {
    static constexpr bool PERM = true;
    bf16_t* act; const float* ss; const float* cw; const float* cb;
    __device__ __forceinline__ void operator()(f32x4 (&acc)[2][2][4][2], const pg8::Unit& u, int wr, int wc, int fr, int fq) const {
        extern __shared__ __attribute__((aligned(16))) unsigned char lds_raw_[];
        LAS f32x4* xch = (LAS f32x4*)((LAS unsigned char*)lds_raw_ + LDS_XCH);
        const int R0 = 254 * u.pm - 2;
        rstd_table(ss, R0, 1.0f, wr, wc, fr, fq);
#pragma unroll
        for (int ai = 0; ai < 2; ++ai)
#pragma unroll
            for (int m = 0; m < 4; ++m) { const float rs = rstd_get(wr * 64 + fr + ai * 128 + m * 16);
#pragma unroll
                for (int bj = 0; bj < 2; ++bj) { acc[ai][bj][m][0] = acc[ai][bj][m][0] * rs; acc[ai][bj][m][1] = acc[ai][bj][m][1] * rs; } }
        if (fr >= 14) {
#pragma unroll
            for (int ai = 0; ai < 2; ++ai) { LAS f32x4* d = xch + ((((2 * ai + wr) * 2 + (fr - 14)) * 4 + wc) * 4 + fq) * 4;
                d[0] = acc[ai][0][3][0]; d[1] = acc[ai][0][3][1]; d[2] = acc[ai][1][3][0]; d[3] = acc[ai][1][3][1]; }
        }
        asm volatile("s_waitcnt lgkmcnt(0)" ::: "memory"); __builtin_amdgcn_s_barrier(); asm volatile("" ::: "memory");
        const int j0 = 128 * u.pn + 32 * wc + 8 * fq;
#pragma unroll
        for (int n = 0; n < 2; ++n) {
            f32x4 wg[3], wv[3];
#pragma unroll
            for (int i = 0; i < 3; ++i) { wg[i] = *(const f32x4*)(cw + (size_t)i * UPC + j0 + 4 * n); wv[i] = *(const f32x4*)(cw + (size_t)i * UPC + FFN + j0 + 4 * n); }
            const f32x4 bg = *(const f32x4*)(cb + j0 + 4 * n), bv = *(const f32x4*)(cb + FFN + j0 + 4 * n);
#pragma unroll
            for (int ai = 0; ai < 2; ++ai)
#pragma unroll
                for (int m = 0; m < 4; ++m) {
                    f32x4 pg, pv;
                    if (m > 0) { pg = acc[ai][0][m - 1][n]; pv = acc[ai][1][m - 1][n]; }
                    else { const int sp = 2 * ai + wr - 1;
                        const LAS f32x4* sp_ = xch + ((((sp < 0 ? 0 : sp) * 2 + (fr & 1)) * 4 + wc) * 4 + fq) * 4;
                        pg = sp_[n]; pv = sp_[2 + n]; }
                    const f32x4 g = acc[ai][0][m][n], v = acc[ai][1][m][n];
                    const int rl = 128 * ai + 64 * wr + 16 * m + fr, row = R0 + rl;
                    float o[4];
#pragma unroll
                    for (int e = 0; e < 4; ++e) {
                        const float g1 = dpp_ror1(fr == 15 ? pg[e] : g[e]), g2 = dpp_ror2(fr >= 14 ? pg[e] : g[e]);
                        const float v1 = dpp_ror1(fr == 15 ? pv[e] : v[e]), v2 = dpp_ror2(fr >= 14 ? pv[e] : v[e]);
                        const float cg_ = bg[e] + wg[0][e] * g2 + wg[1][e] * g1 + wg[2][e] * g[e];
                        const float cv_ = bv[e] + wv[0][e] * v2 + wv[1][e] * v1 + wv[2][e] * v[e];
                        o[e] = cg_ * __builtin_amdgcn_rcpf(1.0f + __builtin_amdgcn_exp2f(cg_ * -1.4426950408889634f)) * cv_;
                    }
                    if (rl >= 2 && row < SEQ) { u32x2 w; w.x = cvt_pk_bf16(o[0], o[1]); w.y = cvt_pk_bf16(o[2], o[3]); *(u32x2*)(act + (size_t)row * FFN + j0 + 4 * n) = w; }
                }
        }
    }
};

__device__ __forceinline__ float bf2f(unsigned short b) { return __uint_as_float((unsigned)b << 16); }
__device__ __forceinline__ float wave_sum(float v) {
#pragma unroll
    for (int o = 1; o < 64; o <<= 1) v += __shfl_xor(v, o);
    return v;
}
__device__ __forceinline__ unsigned off_a(unsigned row, unsigned ch) { return 2048u * (row >> 3) + 512u * (ch >> 2) + 64u * (row & 7) + 16u * ((ch & 3) ^ ((row >> 2) & 3)); }
__device__ __forceinline__ unsigned off_b(unsigned row, unsigned ch) { return 256u * row + 16u * (ch ^ (((row & 3) << 2) | ((row >> 2) & 3))); }
__device__ __forceinline__ int crow(int r, int hi) { return (r & 3) + 8 * (r >> 2) + 4 * hi; }
__device__ __forceinline__ s16x4 vtr(const LAS char* p) { return __builtin_bit_cast(s16x4, __builtin_amdgcn_ds_read_tr16_b64_v4i16((LAS s16x4*)p)); }


typedef unsigned v4u_xb __attribute__((ext_vector_type(4)));
#define XB_TMO      128
#define XB_XCNT(j)  (256  + 64 * (j))
#define XB_XSUB(j)  (1280 + 64 * (j))
#define XB_XGEN(j)  (2304 + 64 * (j))
#define XB_TOP      3328
#define XB_TOPGEN   3392
#define XCD_BAR_WORDS 3456
#define XB_SPIN_CAP (1u << 22)
__device__ __forceinline__ unsigned xb_ld(unsigned* p)              { return __hip_atomic_load(p, __ATOMIC_RELAXED, __HIP_MEMORY_SCOPE_AGENT); }
__device__ __forceinline__ unsigned xb_add(unsigned* p, unsigned v) { return __hip_atomic_fetch_add(p, v, __ATOMIC_RELAXED, __HIP_MEMORY_SCOPE_AGENT); }
__device__ __forceinline__ unsigned xb_xcc_id() { return (unsigned)__builtin_amdgcn_s_getreg((3 << 11) | 20) & 0xFu; }
#define XB_SPIN(cond, bar) do { unsigned _sp = 0; while (cond) { __builtin_amdgcn_s_sleep(1); \
    if ((++_sp & 255u) == 0u) { if (xb_ld(&(bar)[XB_TMO])) break; if (_sp > XB_SPIN_CAP) { atomicAdd(&(bar)[XB_TMO], 1u); break; } } } } while (0)
struct XcdBarrier { unsigned* bar; unsigned x; volatile LAS unsigned* st; };
__device__ __forceinline__ XcdBarrier xcd_barrier_post(unsigned* bar, volatile LAS unsigned* st, int tid) {
    XcdBarrier b; b.bar = bar; b.x = xb_xcc_id(); b.st = st;
    if (tid == 0) (void)xb_add(&bar[XB_XCNT(b.x)], 1u);
    return b;
}
__device__ __forceinline__ void xcd_barrier_complete(unsigned* bar, unsigned x, unsigned& nloc, unsigned& nx) {
    const unsigned G = gridDim.x * gridDim.y * gridDim.z;
    unsigned sum, cnt, mine, sp = 0u;
    for (;;) {
        sum = 0u; cnt = 0u; mine = 0u;
#pragma unroll
        for (unsigned j = 0; j < 16; ++j) { const unsigned c = xb_ld(&bar[XB_XCNT(j)]); sum += c; cnt += (c > 0u) ? 1u : 0u; mine = (j == x) ? c : mine; }
        if (sum == G) break;
        __builtin_amdgcn_s_sleep(1);
        if ((++sp & 255u) == 0u) { if (xb_ld(&bar[XB_TMO])) break; if (sp > XB_SPIN_CAP) { atomicAdd(&bar[XB_TMO], 1u); break; } }
    }
    nloc = mine > 0u ? mine : 1u; nx = cnt > 0u ? cnt : 1u;
}
__device__ __forceinline__ void xcd_barrier(const XcdBarrier& b, int tid) {
    asm volatile("s_waitcnt vmcnt(0)" ::: "memory");
    __syncthreads();
    if (tid == 0) {
        unsigned* bar = b.bar;
        __builtin_amdgcn_s_waitcnt(0);
        unsigned nloc = b.st[0], nx = b.st[1];
        if (nloc == 0u) { xcd_barrier_complete(bar, b.x, nloc, nx); b.st[0] = nloc; b.st[1] = nx; }
        const unsigned old = xb_add(&bar[XB_XSUB(b.x)], 1u);
        const unsigned gen = old / nloc;
        if (old + 1u == (gen + 1u) * nloc) {
            __builtin_amdgcn_fence(__ATOMIC_RELEASE, "agent");
            asm volatile("s_waitcnt vmcnt(0)" ::: "memory");
            const unsigned og = xb_add(&bar[XB_TOP], 1u);
            const unsigned tg = og / nx;
            if (og + 1u == (tg + 1u) * nx) xb_add(&bar[XB_TOPGEN], 1u);
            else XB_SPIN(xb_ld(&bar[XB_TOPGEN]) == tg, bar);
            __builtin_amdgcn_fence(__ATOMIC_ACQUIRE, "agent");
            xb_add(&bar[XB_XGEN(b.x)], 1u);
            asm volatile("s_waitcnt vmcnt(0)" ::: "memory");
        } else {
            XB_SPIN(xb_ld(&bar[XB_XGEN(b.x)]) == gen, bar);
            __builtin_amdgcn_fence(__ATOMIC_ACQUIRE, "agent");
            asm volatile("s_waitcnt vmcnt(0)" ::: "memory");
        }
    }
    __syncthreads();
}

struct Params {
    const float* in[19];
    float* out; unsigned char* ws;
    int ph_lo, ph_hi;
};

__device__ __forceinline__ void transpose_item(const float* W, int K, int N, bf16_t* WT, int dst_row0, const float* gscale, LAS float* scr, int k0, int n0, int lane) {
    f32x4 v[16];
    const int kr = lane >> 4, c4 = 4 * (lane & 15);
#pragma unroll
    for (int i = 0; i < 16; ++i) v[i] = *(const f32x4*)(W + (size_t)(k0 + 4 * i + kr) * N + n0 + c4);
#pragma unroll
    for (int i = 0; i < 16; ++i) { const int kk = 4 * i + kr; const float g = gscale ? gscale[k0 + kk] : 1.0f; LAS float* d = scr + kk * 65 + c4;
        d[0] = v[i][0] * g; d[1] = v[i][1] * g; d[2] = v[i][2] * g; d[3] = v[i][3] * g; }
    CFENCE();
    const int c = lane & 7;
#pragma unroll
    for (int j = 0; j < 8; ++j) { const int n = (lane >> 3) + 8 * j; const LAS float* s = scr + (8 * c) * 65 + n;
        u32x4 o; o.x = cvt_pk_bf16(s[0 * 65], s[1 * 65]); o.y = cvt_pk_bf16(s[2 * 65], s[3 * 65]); o.z = cvt_pk_bf16(s[4 * 65], s[5 * 65]); o.w = cvt_pk_bf16(s[6 * 65], s[7 * 65]);
        *(u32x4*)(WT + (size_t)(dst_row0 + n) * K + k0 + 8 * c) = o; }
    CFENCE();
}
__device__ __forceinline__ void sincos_d(double a, float& c, float& s) {
    const double TWO_PI = 6.283185307179586476925286766559, INV = 0.15915494309189533576888376337251;
    const double k = __builtin_rint(a * INV); const double r = a - k * TWO_PI;
    const double r2 = r * r;
    double sn = 1.0, cs = 1.0;
    double ts = 1.0, tc = 1.0;
    sn = 0.0; cs = 0.0;
#pragma unroll
    for (int n = 13; n >= 1; --n) { ts = 1.0 - ts * r2 / (double)((2 * n) * (2 * n + 1)); tc = 1.0 - tc * r2 / (double)((2 * n - 1) * (2 * n)); }
    sn = r * ts; cs = tc;
    c = (float)cs; s = (float)sn;
}
__device__ __forceinline__ void prologue(const Params& p, unsigned char* ws, LAS unsigned char* lds, int gw, int NGW, int wid, int lane) {
    LAS float* scr = (LAS float*)(lds + wid * 16640);
    constexpr int I_IN = (DM / 64) * (INC / 64), I_OUT = (DM / 64) * (DM / 64), I_UP = (DM / 64) * (UPC / 64), I_DN = (FFN / 64) * (DM / 64);
    constexpr int I_L = I_IN + I_OUT + I_UP + I_DN;
    for (int it = gw; it < DEPTH * I_L; it += NGW) {
        const int l = it / I_L; int r = it % I_L;
        if (r < I_IN) { const int nb = INC / 64, kb = r / nb, n0 = 64 * (r % nb);
            transpose_item(p.in[2] + (size_t)l * DM * INC, DM, INC, (bf16_t*)(ws + WS_WIN + l * SZ_WIN), n0, p.in[1] + l * DM, scr, 64 * kb, n0, lane); continue; }
        r -= I_IN;
        if (r < I_OUT) { const int nb = DM / 64, kb = r / nb, n0 = 64 * (r % nb);
            transpose_item(p.in[12] + (size_t)l * DM * DM, DM, DM, (bf16_t*)(ws + WS_WOUT + l * SZ_WOUT), n0, nullptr, scr, 64 * kb, n0, lane); continue; }
        r -= I_OUT;
        if (r < I_UP) { const int nb = UPC / 64, kb = r / nb, n0 = 64 * (r % nb);
            const int j = (n0 < FFN) ? n0 : n0 - FFN; const int dst = 256 * (j / 128) + (j % 128) + ((n0 < FFN) ? 0 : 128);
            transpose_item(p.in[14] + (size_t)l * DM * UPC, DM, UPC, (bf16_t*)(ws + WS_WUP + l * SZ_WUP), dst, p.in[13] + l * DM, scr, 64 * kb, n0, lane); continue; }
        r -= I_UP;
        { const int nb = DM / 64, kb = r / nb, n0 = 64 * (r % nb);
            transpose_item(p.in[17] + (size_t)l * FFN * DM, FFN, DM, (bf16_t*)(ws + WS_WDN + l * SZ_WDN), n0, nullptr, scr, 64 * kb, n0, lane); }
    }
    bf16_t* xb = (bf16_t*)(ws + WS_XB0 + XB_PAD); float* ss = (float*)(ws + WS_SS);
    for (int m = gw; m < SEQ; m += NGW) {
        const f32x4* xr = (const f32x4*)(p.in[0] + (size_t)m * DM) + lane; f32x4* orow = (f32x4*)(p.out + (size_t)m * DM) + lane;
        u32x2* brow = (u32x2*)(xb + (size_t)m * DM) + lane; float s = 0.f;
#pragma unroll
        for (int j = 0; j < 8; ++j) { const f32x4 v = xr[64 * j]; orow[64 * j] = v; s += (v[0] * v[0] + v[1] * v[1]) + (v[2] * v[2] + v[3] * v[3]);
            u32x2 w; w.x = cvt_pk_bf16(v[0], v[1]); w.y = cvt_pk_bf16(v[2], v[3]); brow[64 * j] = w; }
        s = wave_sum(s); if (lane < 32) ss[(size_t)m * 32 + lane] = (lane == 0) ? s : 0.f;
    }
    for (int m = gw; m < 512; m += NGW) {
        u32x4* prow = (u32x4*)(ws + WS_XB0 + (m < 256 ? (size_t)m * DM * 2 : XB_PAD + (size_t)(SEQ + m - 256) * DM * 2)) + lane;
#pragma unroll
        for (int j = 0; j < 4; ++j) prow[64 * j] = (u32x4){0u, 0u, 0u, 0u};
    }
    const float invA[16] = {1.000000000e+00f, 4.403666258e-01f, 1.939227581e-01f, 8.539710194e-02f, 3.760603070e-02f, 1.656044088e-02f, 7.292665076e-03f, 3.211446106e-03f,
                            1.414213446e-03f, 6.227724371e-04f, 2.742481884e-04f, 1.207697424e-04f, 5.318296462e-05f, 2.341999789e-05f, 1.031338525e-05f, 4.541670478e-06f};
    f32x2* tabA = (f32x2*)(ws + WS_TABA); f32x2* tabB = (f32x2*)(ws + WS_TABB);
    for (int i = gw * 64 + lane; i < SEQ * 16; i += NGW * 64) {
        const int t = i >> 4, k = i & 15; float inv = 0.f;
#pragma unroll
        for (int q = 0; q < 16; ++q) inv = (k == q) ? invA[q] : inv;
        const float ang = (float)t * inv; float c, s; sincos_d((double)ang, c, s); tabA[i] = (f32x2){c, s};
        if ((k & 1) == 0) tabB[t * 8 + (k >> 1)] = (f32x2){c, s};
    }
}

__device__ __forceinline__ void load_v_regs(u32x4 (&r)[8], const bf16_t* vbase  , int kbase, int kstride, int lane) {
#pragma unroll
    for (int i = 0; i < 8; ++i) { const int cid = lane + 64 * i, row = cid >> 4, ch = cid & 15; int tok = kbase + row * kstride; tok = tok < 0 ? 0 : (tok > SEQ - 1 ? SEQ - 1 : tok);
        r[i] = *(const u32x4*)(vbase + (size_t)tok * LDP + 8 * ch); }
}
__device__ __forceinline__ void store_v_tile(const u32x4 (&r)[8], LAS char* vt, int lane) {
#pragma unroll
    for (int i = 0; i < 8; ++i) { const int cid = lane + 64 * i, row = cid >> 4, ch = cid & 15; *(LAS u32x4*)(vt + off_b(row, ch)) = r[i]; }
    asm volatile("s_waitcnt lgkmcnt(0)" ::: "memory");
}
__device__ __forceinline__ void vfrag_bases(const LAS char* vt, int lane, const LAS char*& vb0, const LAS char*& vb1) {
    const int hi = lane >> 5, blk = (lane >> 4) & 1, q = (lane & 15) >> 2, pp = lane & 3;
    const int c = 2 * blk + (pp >> 1);
    vb0 = vt + 64 * (4 * hi + q) + 16 * (c ^ hi) + 8 * (pp & 1);
    vb1 = vt + 64 * (4 * hi + q) + 16 * (c ^ (2 + hi)) + 8 * (pp & 1);
}
__device__ __forceinline__ bf16x8 vfrag(const LAS char* vb0, const LAS char* vb1, int dt, int ks) {
    const s16x4 lo = vtr(vb0 + 4096 * ks + 512 * dt);
    const s16x4 hv = vtr(vb1 + 4096 * ks + 2048 + 512 * dt);
    return (bf16x8){lo[0], lo[1], lo[2], lo[3], hv[0], hv[1], hv[2], hv[3]};
}
__device__ __forceinline__ void softmax_tile(f32x16& s, float& m, float& l, float& alpha, bf16x8& p0, bf16x8& p1) {
    float tm = s[0];
#pragma unroll
    for (int r = 1; r < 16; ++r) tm = fmaxf(tm, s[r]);
    { auto rr = __builtin_amdgcn_permlane32_swap(__float_as_uint(tm), __float_as_uint(tm), false, false); tm = fmaxf(__uint_as_float(rr[0]), __uint_as_float(rr[1])); }
    const float mn = (tm > m + 8.0f) ? tm : m;
    alpha = __builtin_amdgcn_exp2f(m - mn);
    float rs = 0.f;
#pragma unroll
    for (int r = 0; r < 16; ++r) { s[r] = __builtin_amdgcn_exp2f(s[r] - mn); rs += s[r]; }
    { auto rr = __builtin_amdgcn_permlane32_swap(__float_as_uint(rs), __float_as_uint(rs), false, false); rs = __uint_as_float(rr[0]) + __uint_as_float(rr[1]); }
    l = l * alpha + rs; m = mn;
    u32x4 a, b;
    a.x = cvt_pk_hw(s[0], s[1]); a.y = cvt_pk_hw(s[2], s[3]); a.z = cvt_pk_hw(s[4], s[5]); a.w = cvt_pk_hw(s[6], s[7]);
    b.x = cvt_pk_hw(s[8], s[9]); b.y = cvt_pk_hw(s[10], s[11]); b.z = cvt_pk_hw(s[12], s[13]); b.w = cvt_pk_hw(s[14], s[15]);
    p0 = __builtin_bit_cast(bf16x8, a); p1 = __builtin_bit_cast(bf16x8, b);
}

__device__ __forceinline__ void mixerA_unit(const bf16_t* Hq, bf16_t* mix, int head, int rho, int blk, LAS char* vt, int lane) {
    asm volatile("" : "+v"(lane));
    const int r32 = lane & 31, hi = lane >> 5;
    const int tq = rho + 16 * (32 * blk + r32);
    const bf16_t* qrow = Hq + ((size_t)(0 * 6 + head) * SEQ + tq) * HLD + 8 * hi;
    bf16x8 qf[8];
#pragma unroll
    for (int s = 0; s < 8; ++s) qf[s] = *(const bf16x8*)(qrow + 16 * s);
    f32x16 o[4];
#pragma unroll
    for (int d = 0; d < 4; ++d)
#pragma unroll
        for (int r = 0; r < 16; ++r) o[d][r] = 0.f;
    float m = NEGBIG, l = 0.f;
    const bf16_t* kcol = Hq + (size_t)(1 * 6 + head) * HSZ + 8 * hi;
    const bf16_t* vcol = Hq + (size_t)(2 * 6 + head) * HSZ;
#define A_TILE(it_, kbase_, kstride_, W_) do { if ((it_) < 5) { const int k_ = 4 - (it_); kstride_ = 16; W_ = 2048; kbase_ = rho + 16 * (32 * blk - 128 + 32 * k_); } \
        else if ((it_) < 13) { const int k_ = (it_) - 5; kstride_ = 4; W_ = 512; kbase_ = (rho & 3) + 4 * ((rho >> 2) + 128 * blk - 128 + 32 * k_); } \
        else { const int k_ = (it_) - 13; kstride_ = 1; W_ = 128; kbase_ = rho + 512 * blk - 128 + 32 * k_; } } while (0)
#define A_KLOAD(dst_, kbase_, kstride_) do { int tokk_ = (kbase_) + r32 * (kstride_); tokk_ = tokk_ < 0 ? 0 : (tokk_ > SEQ - 1 ? SEQ - 1 : tokk_); const bf16_t* krow_ = kcol + (size_t)tokk_ * HLD; \
        _Pragma("unroll") for (int s_ = 0; s_ < 8; ++s_) dst_[s_] = *(const bf16x8*)(krow_ + 16 * s_); } while (0)
    const char* vbase_u = (const char*)vcol;
    const unsigned a_rl = (unsigned)((lane >> 2) & 7);
    const unsigned a_cA = (unsigned)(16 * (4 * (lane >> 5) + ((lane & 3) ^ ((lane >> 4) & 1)))), a_cB = (unsigned)(16 * (4 * (lane >> 5) + ((lane & 3) ^ (2 + ((lane >> 4) & 1)))));
#define A_DMA_V(kbase_, kstride_, buf_) do { \
        if ((kbase_) >= 0 && (kbase_) + 31 * (kstride_) <= SEQ - 1) { \
            const char* vg_ = vbase_u + (size_t)(kbase_) * 256; const unsigned rs_ = (unsigned)(kstride_) * 256u; const unsigned oA_ = a_rl * rs_ + a_cA, oB_ = a_rl * rs_ + a_cB; \
            _Pragma("unroll") for (int i_ = 0; i_ < 8; ++i_) \
                __builtin_amdgcn_global_load_lds((const unsigned*)((vg_ + ((size_t)(8 * (i_ >> 1)) * rs_ + 128 * (i_ & 1))) + (((i_ >> 1) & 1) ? oB_ : oA_)), (LAS unsigned*)(vt + (buf_) * 8192 + i_ * 1024), 16, 0, 0); \
        } else { _Pragma("unroll") for (int i_ = 0; i_ < 8; ++i_) { \
            const int row_ = 8 * (i_ >> 1) + ((lane >> 2) & 7); const int ch_ = 4 * (2 * (i_ & 1) + (lane >> 5)) + ((lane & 3) ^ ((row_ >> 2) & 3)); \
            int tokv_ = (kbase_) + row_ * (kstride_); tokv_ = tokv_ < 0 ? 0 : (tokv_ > SEQ - 1 ? SEQ - 1 : tokv_); \
            __builtin_amdgcn_global_load_lds((const unsigned*)(vcol + (size_t)tokv_ * HLD + 8 * ch_), (LAS unsigned*)(vt + (buf_) * 8192 + i_ * 1024), 16, 0, 0); } } } while (0)
    const LAS char *va0, *va1; vfrag_bases((const LAS char*)vt, lane, va0, va1);
    bf16x8 kfn[8];
    int cur = 0;
    { int kb0, ks0, w0; A_TILE(0, kb0, ks0, w0); (void)w0; A_DMA_V(kb0, ks0, 0); A_KLOAD(kfn, kb0, ks0); }
    for (int it = 0; it < 33; ++it) {
        int kbase, kstride, W;
        A_TILE(it, kbase, kstride, W);
        bf16x8 kf[8];
#pragma unroll
        for (int s = 0; s < 8; ++s) kf[s] = kfn[s];
        if (it + 1 < 33) { int kb1, ks1, w1; A_TILE(it + 1, kb1, ks1, w1); (void)w1; A_DMA_V(kb1, ks1, cur ^ 1); A_KLOAD(kfn, kb1, ks1); }
        __builtin_amdgcn_sched_barrier(0);
        f32x16 sc;
#pragma unroll
        for (int r = 0; r < 16; ++r) sc[r] = 0.f;
#pragma unroll
        for (int s = 0; s < 8; ++s) sc = __builtin_amdgcn_mfma_f32_32x32x16_bf16(kf[s], qf[s], sc, 0, 0, 0);
        { const int dbase = tq - kbase - 4 * hi * kstride; const unsigned lim = (unsigned)(W < tq ? W : tq);
#pragma unroll
          for (int r = 0; r < 16; ++r) { const unsigned df = (unsigned)(dbase - ((r & 3) + 8 * (r >> 2)) * kstride); sc[r] = (df <= lim) ? sc[r] : NEGBIG; } }
        float alpha; bf16x8 p0, p1;
        softmax_tile(sc, m, l, alpha, p0, p1);
        if (it + 1 < 33) asm volatile("s_waitcnt vmcnt(16)" ::: "memory"); else asm volatile("s_waitcnt vmcnt(0)" ::: "memory");
        if (__any(alpha != 1.0f)) {
#pragma unroll
            for (int d = 0; d < 4; ++d)
#pragma unroll
                for (int r = 0; r < 16; ++r) o[d][r] *= alpha;
        }
#pragma unroll
        for (int d = 0; d < 4; ++d) {
            const bf16x8 v0 = vfrag(va0 + cur * 8192, va1 + cur * 8192, d, 0), v1 = vfrag(va0 + cur * 8192, va1 + cur * 8192, d, 1);
            o[d] = __builtin_amdgcn_mfma_f32_32x32x16_bf16(v0, p0, o[d], 0, 0, 0);
            o[d] = __builtin_amdgcn_mfma_f32_32x32x16_bf16(v1, p1, o[d], 0, 0, 0);
        }
        CFENCE();
        cur ^= 1;
    }
    const float il = 1.0f / l;
    bf16_t* orow = mix + (size_t)tq * DM + head * 128 + 4 * hi;
#pragma unroll
    for (int d = 0; d < 4; ++d)
#pragma unroll
        for (int g = 0; g < 4; ++g) {
            u32x2 w; w.x = cvt_pk_bf16(o[d][4 * g] * il, o[d][4 * g + 1] * il); w.y = cvt_pk_bf16(o[d][4 * g + 2] * il, o[d][4 * g + 3] * il);
            *(u32x2*)(orow + 32 * d + 8 * g) = w;
        }
}

constexpr int B_TAB_W = 3;
__device__ const unsigned short b_list[8 * 96] = {
127,126,125,124,123,122,121,120,119,118,117,116,115,114,113,112,111,110,109,108,107,106,105,104,103,102,101,100,99,98,97,96,95,94,93,92,91,90,89,88,87,86,85,84,83,82,81,80,47,46,45,44,43,42,41,40,39,38,37,36,35,34,33,32,31,30,29,28,27,26,25,24,23,22,21,20,19,18,17,16,15,14,13,12,11,10,9,8,7,6,5,4,3,2,1,0,
255,254,253,252,251,250,249,248,247,246,245,244,243,242,241,240,239,238,237,236,235,234,233,232,231,230,229,228,227,226,225,224,79,78,77,76,75,74,73,72,71,70,69,68,67,66,65,64,63,62,61,60,59,58,57,56,55,54,53,52,51,50,49,48,159,158,157,156,155,154,153,152,151,150,149,148,147,146,145,144,143,142,141,140,139,138,137,136,135,134,133,132,131,130,129,128,
383,382,381,380,379,378,377,376,375,374,373,372,371,370,369,368,223,222,221,220,219,218,217,216,215,214,213,212,211,210,209,208,207,206,205,204,203,202,201,200,199,198,197,196,195,194,193,192,191,190,189,188,187,186,185,184,183,182,181,180,179,178,177,176,175,174,173,172,171,170,169,168,167,166,165,164,163,162,161,160,271,270,269,268,267,266,265,264,263,262,261,260,259,258,257,256,
367,366,365,364,363,362,361,360,359,358,357,356,355,354,353,352,351,350,349,348,347,346,345,344,343,342,341,340,339,338,337,336,335,334,333,332,331,330,329,328,327,326,325,324,323,322,321,320,319,318,317,316,315,314,313,312,311,310,309,308,307,306,305,304,303,302,301,300,299,298,297,296,295,294,293,292,291,290,289,288,287,286,285,284,283,282,281,280,279,278,277,276,275,274,273,272,
511,510,509,508,507,506,505,504,503,502,501,500,499,498,497,496,495,494,493,492,491,490,489,488,487,486,485,484,483,482,481,480,479,478,477,476,475,474,473,472,471,470,469,468,467,466,465,464,431,430,429,428,427,426,425,424,423,422,421,420,419,418,417,416,415,414,413,412,411,410,409,408,407,406,405,404,403,402,401,400,399,398,397,396,395,394,393,392,391,390,389,388,387,386,385,384,
639,638,637,636,635,634,633,632,631,630,629,628,627,626,625,624,623,622,621,620,619,618,617,616,615,614,613,612,611,610,609,608,463,462,461,460,459,458,457,456,455,454,453,452,451,450,449,448,447,446,445,444,443,442,441,440,439,438,437,436,435,434,433,432,543,542,541,540,539,538,537,536,535,534,533,532,531,530,529,528,527,526,525,524,523,522,521,520,519,518,517,516,515,514,513,512,
767,766,765,764,763,762,761,760,759,758,757,756,755,754,753,752,607,606,605,604,603,602,601,600,599,598,597,596,595,594,593,592,591,590,589,588,587,586,585,584,583,582,581,580,579,578,577,576,575,574,573,572,571,570,569,568,567,566,565,564,563,562,561,560,559,558,557,556,555,554,553,552,551,550,549,548,547,546,545,544,655,654,653,652,651,650,649,648,647,646,645,644,643,642,641,640,
751,750,749,748,747,746,745,744,743,742,741,740,739,738,737,736,735,734,733,732,731,730,729,728,727,726,725,724,723,722,721,720,719,718,717,716,715,714,713,712,711,710,709,708,707,706,705,704,703,702,701,700,699,698,697,696,695,694,693,692,691,690,689,688,687,686,685,684,683,682,681,680,679,678,677,676,675,674,673,672,671,670,669,668,667,666,665,664,663,662,661,660,659,658,657,656};
constexpr int LDS_Q = 131072, LDS_ST = 147456;
__device__ __forceinline__ void mixerB_subunit(const bf16_t* Hq, bf16_t* mix, f32x4* o1g, int head, int qb, float lam, float om_li, const float* subln, LAS unsigned char* lds, int wid, int lane) {
    asm volatile("" : "+v"(lane));
    const int tid = wid * 64 + lane, r32 = lane & 31, hi = lane >> 5;
    __syncthreads();
#pragma unroll
    for (int j = 0; j < 2; ++j) { const int cidx = tid + 512 * j, row = cidx >> 4, ch = cidx & 15;
      const u32x4 v = *(const u32x4*)(Hq + ((size_t)(3 * 6 + head) * SEQ + qb * 64 + row) * HLD + 8 * ch);
      *(LAS u32x4*)(lds + LDS_Q + (row >> 5) * 8192 + off_a(row & 31, ch)) = v; }
    LAS unsigned char* vb = lds + wid * 16384;
    const bf16_t* vcol = Hq + (size_t)(5 * 6 + head) * HSZ;
    const int nt = 2 * qb + 2;
    const unsigned voffA = (unsigned)(((lane >> 2) & 7) * 256 + 16 * (4 * (lane >> 5) + ((lane & 3) ^ ((lane >> 4) & 1))));
    const unsigned voffB = (unsigned)(((lane >> 2) & 7) * 256 + 16 * (4 * (lane >> 5) + ((lane & 3) ^ (2 + ((lane >> 4) & 1)))));
    const char* vbase_u = (const char*)vcol;
#define B_DMA_V(kbase_, buf_, ln_) do { const char* vg_ = vbase_u + (size_t)(kbase_) * 256; _Pragma("unroll") for (int i_ = 0; i_ < 8; ++i_) \
        __builtin_amdgcn_global_load_lds((const unsigned*)((vg_ + (2048 * (i_ >> 1) + 128 * (i_ & 1))) + (((i_ >> 1) & 1) ? voffB : voffA)), (LAS unsigned*)(vb + (buf_) * 8192 + i_ * 1024), 16, 0, 0); } while (0)
    const LAS char *vb0, *vb1; vfrag_bases((const LAS char*)vb, lane, vb0, vb1);
    const LAS unsigned char* qb0 = lds + LDS_Q + 2048 * (r32 >> 3) + 64 * (r32 & 7) + 16 * (hi ^ ((r32 >> 2) & 3));
    const LAS unsigned char* qb1 = lds + LDS_Q + 2048 * (r32 >> 3) + 64 * (r32 & 7) + 16 * ((2 + hi) ^ ((r32 >> 2) & 3));
#pragma unroll 1
    for (int mp = 0; mp < 2; ++mp) {
        __syncthreads();
        f32x16 o[2][4];
#pragma unroll
        for (int h = 0; h < 2; ++h)
#pragma unroll
            for (int d = 0; d < 4; ++d)
#pragma unroll
                for (int r = 0; r < 16; ++r) o[h][d][r] = 0.f;
        float m[2] = {NEGBIG, NEGBIG}, l[2] = {0.f, 0.f};
        const bf16_t* kcol0 = Hq + (size_t)(4 * 6 + head) * HSZ + 64 * mp;
        int cur = 0;
        if (wid < nt) { B_DMA_V(wid * 32, 0, lane); }
        for (int kt = wid; kt < nt; kt += 8) {
            const int kbase = kt * 32;
            const bool has_next = (kt + 8 < nt);
            int ln = lane; asm volatile("" : "+v"(ln));
            const int r32 = ln & 31, hi = ln >> 5;
            bf16x8 kf[4];
            { const bf16_t* krow = kcol0 + 8 * hi + (size_t)(kbase + r32) * HLD;
#pragma unroll
              for (int s = 0; s < 4; ++s) kf[s] = *(const bf16x8*)(krow + 16 * s); }
            __builtin_amdgcn_sched_barrier(0);
#pragma unroll
            for (int h = 0; h < 2; ++h) {
                f32x16 sc;
#pragma unroll
                for (int r = 0; r < 16; ++r) sc[r] = 0.f;
                __builtin_amdgcn_s_setprio(1);
#pragma unroll
                for (int s = 0; s < 4; ++s) { const bf16x8 qf = *(const LAS bf16x8*)(((s & 1) ? qb1 : qb0) + h * 8192 + 512 * (2 * mp + (s >> 1))); sc = __builtin_amdgcn_mfma_f32_32x32x16_bf16(kf[s], qf, sc, 0, 0, 0); }
                __builtin_amdgcn_s_setprio(0);
                if (h == 0 && has_next) { B_DMA_V(kbase + 256, cur ^ 1, ln); }
                if (kt >= 2 * qb) {
                    const int tq = qb * 64 + 32 * h + r32;
#pragma unroll
                    for (int r = 0; r < 16; ++r) { const bool ok = (kbase + crow(r, hi)) <= tq; sc[r] = ok ? sc[r] : NEGBIG; }
                }
                float alpha; bf16x8 p0, p1;
                softmax_tile(sc, m[h], l[h], alpha, p0, p1);
                if (h == 0) { if (has_next) asm volatile("s_waitcnt vmcnt(8)" ::: "memory"); else asm volatile("s_waitcnt vmcnt(0)" ::: "memory"); }
                if (__any(alpha != 1.0f)) {
#pragma unroll
                    for (int d = 0; d < 4; ++d)
#pragma unroll
                        for (int r = 0; r < 16; ++r) o[h][d][r] *= alpha;
                }
                __builtin_amdgcn_s_setprio(1);
#pragma unroll
                for (int d = 0; d < 4; ++d) {
                    const bf16x8 v0 = vfrag(vb0 + cur * 8192, vb1 + cur * 8192, d, 0), v1 = vfrag(vb0 + cur * 8192, vb1 + cur * 8192, d, 1);
                    o[h][d] = __builtin_amdgcn_mfma_f32_32x32x16_bf16(v0, p0, o[h][d], 0, 0, 0);
                    o[h][d] = __builtin_amdgcn_mfma_f32_32x32x16_bf16(v1, p1, o[h][d], 0, 0, 0);
                }
                __builtin_amdgcn_s_setprio(0);
            }
            CFENCE();
            cur ^= 1;
        }
#pragma unroll
        for (int st = 4; st >= 1; st >>= 1) {
            __syncthreads();
            if (wid >= st && wid < 2 * st) {
                LAS f32x4* sl = (LAS f32x4*)(lds + (wid - st) * 32768) + lane;
#pragma unroll
                for (int h = 0; h < 2; ++h)
#pragma unroll
                    for (int d = 0; d < 4; ++d)
#pragma unroll
                        for (int g = 0; g < 4; ++g) sl[(h * 16 + d * 4 + g) * 64] = (f32x4){o[h][d][4 * g], o[h][d][4 * g + 1], o[h][d][4 * g + 2], o[h][d][4 * g + 3]};
                LAS float* sp = (LAS float*)(lds + LDS_ST + (wid - st) * 1024) + lane;
                sp[0] = m[0]; sp[64] = l[0]; sp[128] = m[1]; sp[192] = l[1];
            }
            __syncthreads();
            if (wid < st) {
                const LAS f32x4* sl = (const LAS f32x4*)(lds + wid * 32768) + lane;
                const LAS float* sp = (const LAS float*)(lds + LDS_ST + wid * 1024) + lane;
#pragma unroll
                for (int h = 0; h < 2; ++h) {
                    const float bm = sp[128 * h], bl = sp[128 * h + 64];
                    const float n = fmaxf(m[h], bm);
                    const float fa = __builtin_amdgcn_exp2f(m[h] - n), fb = __builtin_amdgcn_exp2f(bm - n);
                    l[h] = l[h] * fa + bl * fb; m[h] = n;
#pragma unroll
                    for (int d = 0; d < 4; ++d)
#pragma unroll
                        for (int g = 0; g < 4; ++g) {
                            const f32x4 b1 = sl[(h * 16 + d * 4 + g) * 64];
#pragma unroll
                            for (int e = 0; e < 4; ++e) o[h][d][4 * g + e] = o[h][d][4 * g + e] * fa + b1[e] * fb;
                            CFENCE();
                        }
                }
            }
        }
        if (wid == 0) {
            int lf = lane; asm volatile("" : "+v"(lf));
            const int r32 = lf & 31, hi = lf >> 5;
            f32x4* o1p = o1g + lf;
#pragma unroll
            for (int h = 0; h < 2; ++h) {
                if (mp == 0) {
                    const float i1 = 1.0f / l[h];
#pragma unroll
                    for (int d = 0; d < 4; ++d)
#pragma unroll
                        for (int g = 0; g < 4; ++g) { o1p[(h * 16 + d * 4 + g) * 64] = (f32x4){o[h][d][4 * g] * i1, o[h][d][4 * g + 1] * i1, o[h][d][4 * g + 2] * i1, o[h][d][4 * g + 3] * i1}; CFENCE(); }
                } else {
                    const float i2 = lam / l[h];
                    float sq = 0.f;
#pragma unroll
                    for (int d = 0; d < 4; ++d)
#pragma unroll
                        for (int g = 0; g < 4; ++g) { const f32x4 a = o1p[(h * 16 + d * 4 + g) * 64];
#pragma unroll
                            for (int e = 0; e < 4; ++e) { const float v = a[e] - o[h][d][4 * g + e] * i2; o[h][d][4 * g + e] = v; sq += v * v; }
                            CFENCE(); }
                    { auto rr = __builtin_amdgcn_permlane32_swap(__float_as_uint(sq), __float_as_uint(sq), false, false); sq = __uint_as_float(rr[0]) + __uint_as_float(rr[1]); }
                    const float rn = rsqrtf(sq * (1.0f / 128.0f) + EPS) * om_li;
                    bf16_t* orow = mix + (size_t)(qb * 64 + 32 * h + r32) * DM + 768 + head * 128 + 4 * hi;
#pragma unroll
                    for (int d = 0; d < 4; ++d)
#pragma unroll
                        for (int g = 0; g < 4; ++g) {
                            const f32x4 gw = *(const f32x4*)(subln + 32 * d + 8 * g + 4 * hi);
                            u32x2 w; w.x = cvt_pk_bf16(o[h][d][4 * g] * rn * gw[0], o[h][d][4 * g + 1] * rn * gw[1]); w.y = cvt_pk_bf16(o[h][d][4 * g + 2] * rn * gw[2], o[h][d][4 * g + 3] * rn * gw[3]);
                            *(u32x2*)(orow + 32 * d + 8 * g) = w;
                            CFENCE();
                        }
                }
            }
        }
    }
}

__device__ __forceinline__ void sgu_unit(const bf16_t* P, bf16_t* mix, int c, int g, const float* lng, const float* lnb, const float* Wg  , const float* bs  , LAS unsigned char* lds, int wid, int lane) {
    asm volatile("" : "+v"(lane));
    const int tid = wid * 64 + lane, r32 = lane & 31, hi = lane >> 5;
    constexpr int VS = 272;
    const int ib = wid >> 1, eb0 = 2 * (wid & 1), irow = 32 * ib + r32, nks = 2 * (ib + 1);
    f32x4 wpre[8][2];
#pragma unroll
    for (int s = 0; s < 8; ++s) if (s < nks) { const float* wp = Wg + (size_t)irow * 128 + 16 * s + 8 * hi; wpre[s][0] = *(const f32x4*)wp; wpre[s][1] = *(const f32x4*)(wp + 4); }
    __syncthreads();
    {
        const int j = tid >> 2, part = tid & 3;
        const bf16_t* vrow = P + (size_t)(c * 128 + j) * LDP + C_V;
        float s = 0.f, s2 = 0.f;
#pragma unroll 4
        for (int i = 0; i < 16; ++i) { const u32x4 w = *(const u32x4*)(vrow + part * 128 + 8 * i);
#pragma unroll
            for (int e = 0; e < 4; ++e) { const float a = __uint_as_float(w[e] << 16), b = __uint_as_float(w[e] & 0xffff0000u); s += a + b; s2 += a * a + b * b; } }
        s += __shfl_xor(s, 1); s += __shfl_xor(s, 2); s2 += __shfl_xor(s2, 1); s2 += __shfl_xor(s2, 2);
        const float mean = s * (1.0f / 512.0f); const float var = fmaxf(s2 * (1.0f / 512.0f) - mean * mean, 0.f); const float rstd = rsqrtf(var + EPS);
#pragma unroll
        for (int i = 0; i < 4; ++i) { const int e0 = part * 32 + 8 * i; const u32x4 w = *(const u32x4*)(vrow + g * 128 + e0);
#pragma unroll
            for (int e = 0; e < 4; ++e) { const int ch = g * 128 + e0 + 2 * e;
                const float a = (__uint_as_float(w[e] << 16) - mean) * rstd * lng[ch] + lnb[ch];
                const float b = (__uint_as_float(w[e] & 0xffff0000u) - mean) * rstd * lng[ch + 1] + lnb[ch + 1];
                const unsigned pk = cvt_pk_bf16(a, b);
                *(LAS unsigned short*)(lds + (e0 + 2 * e) * VS + 2 * j) = (unsigned short)(pk & 0xffffu);
                *(LAS unsigned short*)(lds + (e0 + 2 * e + 1) * VS + 2 * j) = (unsigned short)(pk >> 16); } }
    }
    __syncthreads();
    f32x16 acc0, acc1;
#pragma unroll
    for (int r = 0; r < 16; ++r) { acc0[r] = 0.f; acc1[r] = 0.f; }
#pragma unroll
    for (int s = 0; s < 8; ++s) if (s < nks) {
        const f32x4 w0 = wpre[s][0], w1 = wpre[s][1];
        const int j0 = 16 * s + 8 * hi;
        float wv[8] = {w0[0], w0[1], w0[2], w0[3], w1[0], w1[1], w1[2], w1[3]};
#pragma unroll
        for (int e = 0; e < 8; ++e) wv[e] = (j0 + e <= irow) ? wv[e] : 0.f;
        u32x4 aw; aw.x = cvt_pk_hw(wv[0], wv[1]); aw.y = cvt_pk_hw(wv[2], wv[3]); aw.z = cvt_pk_hw(wv[4], wv[5]); aw.w = cvt_pk_hw(wv[6], wv[7]);
        const bf16x8 af = __builtin_bit_cast(bf16x8, aw);
        const bf16x8 b0 = *(const LAS bf16x8*)(lds + (32 * eb0 + r32) * VS + 2 * j0);
        const bf16x8 b1 = *(const LAS bf16x8*)(lds + (32 * (eb0 + 1) + r32) * VS + 2 * j0);
        acc0 = __builtin_amdgcn_mfma_f32_32x32x16_bf16(af, b0, acc0, 0, 0, 0);
        acc1 = __builtin_amdgcn_mfma_f32_32x32x16_bf16(af, b1, acc1, 0, 0, 0);
    }
#pragma unroll
    for (int r = 0; r < 16; ++r) {
        const int i = 32 * ib + crow(r, hi); const int tok = c * 128 + i; const float bb = bs[i];
        const bf16_t* up = P + (size_t)tok * LDP + C_U + g * 128; bf16_t* op = mix + (size_t)tok * DM + 1536 + g * 128;
        const int e0 = 32 * eb0 + r32, e1 = e0 + 32;
        const float y0 = bf2f(up[e0]) * (acc0[r] + bb), y1 = bf2f(up[e1]) * (acc1[r] + bb);
        op[e0] = (bf16_t)(cvt_pk_bf16(y0, 0.f) & 0xffffu); op[e1] = (bf16_t)(cvt_pk_bf16(y1, 0.f) & 0xffffu);
    }
}

__device__ __forceinline__ void mixer_phase(const Params& p, unsigned char* ws, int bx, int G, int l, LAS unsigned char* lds, int wid, int lane) {
    const bf16_t* P = (const bf16_t*)(ws + WS_P); const bf16_t* Hq = (const bf16_t*)(ws + WS_HQKV); bf16_t* mix = (bf16_t*)(ws + WS_MIX);
    const float d1 = wave_sum(p.in[3][l * 64 + lane] * p.in[4][l * 64 + lane]);
    const float d2 = wave_sum(p.in[5][l * 64 + lane] * p.in[6][l * 64 + lane]);
    const float li = (l == 0) ? 0.2f : (l == 1) ? 0.35550906759096934f : (l == 2) ? 0.4707130183435842f : 0.5560582041556406f;
    const float lam = __expf(d1) - __expf(d2) + li;
    LAS char* vt = (LAS char*)(lds + wid * 16384);
    for (int u = bx * 8 + wid; u < 1536; u += G * 8) {
        const int head = u / 256, r = u % 256;
#ifndef SKIP_A
#ifdef COPY_A
        { const int tq_ = (r & 15) + 16 * (32 * (r >> 4) + (lane & 31));
          for (int i_ = 0; i_ < 8; ++i_) *(u32x4*)(mix + (size_t)tq_ * DM + head * 128 + 64 * (lane >> 5) + 8 * i_) = *(const u32x4*)(P + (size_t)tq_ * LDP + C_QA + head * 128 + 64 * (lane >> 5) + 8 * i_); }
#else
        mixerA_unit(Hq, mix, head, r & 15, r >> 4, vt, lane);
#endif
#endif
    }
    __syncthreads();
    for (int u = bx; u < 256; u += G) {
        const int c = u >> 2, g = u & 3;
#ifndef SKIP_C
        sgu_unit(P, mix, c, g, p.in[8] + l * 512, p.in[9] + l * 512, p.in[10] + ((size_t)(l * 4 + g) * 128) * 128, p.in[11] + (l * 4 + g) * 128, lds, wid, lane);
#endif
    }
    f32x4* o1g = (f32x4*)(ws + WS_O1) + (size_t)bx * 2048;
#ifndef SKIP_B
    if (G == 256) {
        unsigned* qc = (unsigned*)(ws + WS_BAR) + 3520 + (l * 8 + (bx & 7)) * 16;
        volatile LAS unsigned* qslot = (volatile LAS unsigned*)(lds + LDS_XB + 16);
        for (;;) {
            __syncthreads();
            if (wid == 0 && lane == 0) *qslot = __hip_atomic_fetch_add(qc, 1u, __ATOMIC_RELAXED, __HIP_MEMORY_SCOPE_AGENT);
            __syncthreads();
            const unsigned idx = *qslot;
            if (idx >= 96u) break;
            const int u = b_list[(bx & 7) * 96 + idx];
            mixerB_subunit(Hq, mix, o1g, u >> 7, u & 127, lam, 1.0f - li, p.in[7] + l * 128, lds, wid, lane);
        }
    } else {
        for (int u = bx; u < 768; u += G) mixerB_subunit(Hq, mix, o1g, u >> 7, 127 - (u & 127), lam, 1.0f - li, p.in[7] + l * 128, lds, wid, lane);
    }
#endif
    __syncthreads();
}

__device__ __forceinline__ void convgate_phase(const Params& p, unsigned char* ws, int bx, int G, int l, int tid) {
    const bf16_t* up = (const bf16_t*)(ws + WS_UP); bf16_t* act = (bf16_t*)(ws + WS_ACT);
    const float* cw = p.in[15] + (size_t)l * 3 * UPC; const float* cb = p.in[16] + (size_t)l * UPC;
    const int nth = G * NTHREADS, gt = bx * NTHREADS + tid;
    constexpr int R = 16, NJ = FFN / 8;
    for (int it = gt; it < (SEQ / R) * NJ; it += nth) {
        const int j0 = 8 * (it % NJ), t0 = R * (it / NJ);
        const int gc = 256 * (j0 >> 7) + (j0 & 127);
        float wg[3][8], wv[3][8], bg[8], bv[8];
#pragma unroll
        for (int i = 0; i < 3; ++i) { const f32x4 a = *(const f32x4*)(cw + (size_t)i * UPC + j0), b = *(const f32x4*)(cw + (size_t)i * UPC + j0 + 4);
            const f32x4 c = *(const f32x4*)(cw + (size_t)i * UPC + FFN + j0), d = *(const f32x4*)(cw + (size_t)i * UPC + FFN + j0 + 4);
#pragma unroll
            for (int e = 0; e < 4; ++e) { wg[i][e] = a[e]; wg[i][4 + e] = b[e]; wv[i][e] = c[e]; wv[i][4 + e] = d[e]; } }
        { const f32x4 a = *(const f32x4*)(cb + j0), b = *(const f32x4*)(cb + j0 + 4), c = *(const f32x4*)(cb + FFN + j0), d = *(const f32x4*)(cb + FFN + j0 + 4);
#pragma unroll
          for (int e = 0; e < 4; ++e) { bg[e] = a[e]; bg[4 + e] = b[e]; bv[e] = c[e]; bv[4 + e] = d[e]; } }
        float g2[8], g1[8], v2[8], v1[8];
#define CG_UNPACK(dst, w) do { _Pragma("unroll") for (int e_ = 0; e_ < 4; ++e_) { dst[2 * e_] = __uint_as_float(w[e_] << 16); dst[2 * e_ + 1] = __uint_as_float(w[e_] & 0xffff0000u); } } while (0)
        if (t0 > 0) {
            const u32x4 a = *(const u32x4*)(up + (size_t)(t0 - 2) * UPC + gc), b = *(const u32x4*)(up + (size_t)(t0 - 2) * UPC + gc + 128);
            const u32x4 c = *(const u32x4*)(up + (size_t)(t0 - 1) * UPC + gc), d = *(const u32x4*)(up + (size_t)(t0 - 1) * UPC + gc + 128);
            CG_UNPACK(g2, a); CG_UNPACK(v2, b); CG_UNPACK(g1, c); CG_UNPACK(v1, d);
        } else {
#pragma unroll
            for (int e = 0; e < 8; ++e) { g2[e] = 0.f; g1[e] = 0.f; v2[e] = 0.f; v1[e] = 0.f; }
        }
#pragma unroll 1
        for (int rb = 0; rb < R; rb += 4) {
            u32x4 rg[4], rv[4];
#pragma unroll
            for (int r = 0; r < 4; ++r) { rg[r] = *(const u32x4*)(up + (size_t)(t0 + rb + r) * UPC + gc); rv[r] = *(const u32x4*)(up + (size_t)(t0 + rb + r) * UPC + gc + 128); }
#pragma unroll
            for (int r = 0; r < 4; ++r) {
                float g0[8], v0[8]; CG_UNPACK(g0, rg[r]); CG_UNPACK(v0, rv[r]);
                float o[8];
#pragma unroll
                for (int e = 0; e < 8; ++e) {
                    const float cg_ = bg[e] + wg[0][e] * g2[e] + wg[1][e] * g1[e] + wg[2][e] * g0[e];
                    const float cv_ = bv[e] + wv[0][e] * v2[e] + wv[1][e] * v1[e] + wv[2][e] * v0[e];
                    o[e] = cg_ / (1.0f + __expf(-cg_)) * cv_;
                    g2[e] = g1[e]; g1[e] = g0[e]; v2[e] = v1[e]; v1[e] = v0[e];
                }
                u32x4 w; w.x = cvt_pk_bf16(o[0], o[1]); w.y = cvt_pk_bf16(o[2], o[3]); w.z = cvt_pk_bf16(o[4], o[5]); w.w = cvt_pk_bf16(o[6], o[7]);
                *(u32x4*)(act + (size_t)(t0 + rb + r) * FFN + j0) = w;
            }
        }
#undef CG_UNPACK
    }
}

__device__ __forceinline__ void final_phase(const Params& p, unsigned char* ws, int gw, int NGW, int lane) {
    const float* ss = (const float*)(ws + WS_SS) + (size_t)8 * SEQ * 32; const f32x4* gf = (const f32x4*)p.in[18] + lane;
    for (int m = gw; m < SEQ; m += NGW) {
        const float rstd = rsqrtf(ss_sum(ss + (size_t)m * 32) * (1.0f / DM) + EPS);
        f32x4* orow = (f32x4*)(p.out + (size_t)m * DM) + lane;
#pragma unroll
        for (int j = 0; j < 8; ++j) { f32x4 v = orow[64 * j]; v = v * rstd * gf[64 * j]; orow[64 * j] = v; }
    }
}

constexpr int N_PHASES = 26;
__global__ void __launch_bounds__(NTHREADS, 2) fwd_kernel(Params p_arg) {
    extern __shared__ __attribute__((aligned(16))) unsigned char lds_raw[];
    LAS unsigned char* lds = (LAS unsigned char*)lds_raw;
    const int ph_lo = p_arg.ph_lo, ph_hi = p_arg.ph_hi;
    volatile LAS unsigned* xst = (volatile LAS unsigned*)(lds + LDS_XB);
    if (threadIdx.x == 0) { xst[0] = 0u; xst[1] = 0u; }
    __syncthreads();
    const XcdBarrier xbar = xcd_barrier_post((unsigned*)(p_arg.ws + WS_BAR), xst, (int)threadIdx.x);
    for (int ph = ph_lo; ph < ph_hi; ++ph) {
        const __attribute__((address_space(4))) Params* pp = (const __attribute__((address_space(4))) Params*)__builtin_amdgcn_kernarg_segment_ptr(); asm volatile("" : "+s"(pp));
        Params p;
#pragma unroll
        for (int i_ = 0; i_ < 19; ++i_) p.in[i_] = (const float*)(const __attribute__((address_space(1))) float*)(pp->in[i_]);
        p.out = (float*)(__attribute__((address_space(1))) float*)(pp->out); p.ws = (unsigned char*)(__attribute__((address_space(1))) unsigned char*)(pp->ws); p.ph_lo = ph_lo; p.ph_hi = ph_hi;
        int tid = threadIdx.x; asm volatile("" : "+v"(tid));
        int bx = blockIdx.x, G = gridDim.x; asm volatile("" : "+s"(bx), "+s"(G));
        unsigned char* ws = p.ws;
        bf16_t* xb = (bf16_t*)(ws + WS_XB0 + XB_PAD); float* ss = (float*)(ws + WS_SS);
        const int lane = tid & 63, wid = __builtin_amdgcn_readfirstlane(tid >> 6);
        const int gw = bx * 8 + wid, NGW = G * 8;
#ifndef SKIP_PRO
        if (ph == 0) { prologue(p, ws, lds, gw, NGW, wid, lane);
#ifdef REP_PRO
            prologue(p, ws, lds, gw, NGW, wid, lane);
#endif
        }
#else
        if (ph == 0) {}
#endif
        else if (ph == 25) final_phase(p, ws, gw, NGW, lane);
        else {
            const int l = (ph - 1) / 6, k = (ph - 1) % 6;
            pg8::StaticOrder S;
#ifndef ONLY_K
#define ONLY_K -1
#endif
            if (k == 0 && (ONLY_K < 0 || ONLY_K == 0)) {
                pg8::Gemm g{xb, (const bf16_t*)(ws + WS_WIN + l * SZ_WIN), SEQ / 256, INC / 256, DM, 256}; S.init(g.nM, g.nN, G, bx);
                EpiInProj E{(bf16_t*)(ws + WS_P), (bf16_t*)(ws + WS_HQKV), ss + (size_t)(2 * l) * SEQ * 32, (const f32x2*)(ws + WS_TABA), (const f32x2*)(ws + WS_TABB)};
                pg8::gemm_phase<EpiInProj>(lds, g, S, E, tid);
            } else if (k == 1) {
                mixer_phase(p, ws, bx, G, l, lds, wid, lane);
#ifdef REP_MIX
                mixer_phase(p, ws, bx, G, l, lds, wid, lane);
#endif
            } else if (k == 2 && (ONLY_K < 0 || ONLY_K == 2)) {
                pg8::Gemm g{(const bf16_t*)(ws + WS_MIX), (const bf16_t*)(ws + WS_WOUT + l * SZ_WOUT), SEQ / 256, DM / 256, DM, 256}; S.init(g.nM, g.nN, G, bx);
                EpiResid E{p.out, xb, ss + (size_t)(2 * l + 1) * SEQ * 32};
                pg8::gemm_phase<EpiResid>(lds, g, S, E, tid);
            } else if (k == 3 && (ONLY_K < 0 || ONLY_K == 3)) {
                pg8::Gemm g{xb - 2 * DM, (const bf16_t*)(ws + WS_WUP + l * SZ_WUP), 33, UPC / 256, DM, 254}; S.init(g.nM, g.nN, G, bx);
                EpiUpConv E{(bf16_t*)(ws + WS_ACT), ss + (size_t)(2 * l + 1) * SEQ * 32, p.in[15] + (size_t)l * 3 * UPC, p.in[16] + (size_t)l * UPC};
                pg8::gemm_phase<EpiUpConv>(lds, g, S, E, tid);
            } else if (k == 4 && (ONLY_K < 0 || ONLY_K == 4)) {
                continue;
            } else if (ONLY_K < 0 || ONLY_K == 5) {
                pg8::Gemm g{(const bf16_t*)(ws + WS_ACT), (const bf16_t*)(ws + WS_WDN + l * SZ_WDN), SEQ / 256, DM / 256, FFN, 256}; S.init(g.nM, g.nN, G, bx);
                EpiResid E{p.out, xb, ss + (size_t)(2 * l + 2) * SEQ * 32};
                pg8::gemm_phase<EpiResid>(lds, g, S, E, tid);
            }
        }
        if (ph + 1 < ph_hi) { if (ph_lo > 0) cg::this_grid().sync(); else xcd_barrier(xbar, tid); }
    }
}

#ifndef MK_PER_PHASE_LAUNCH
#define MK_PER_PHASE_LAUNCH 0
#endif
extern "C" void kernel_launch(void* const* d_in, const int* in_sizes, int n_in, void* d_out, int out_size, void* d_ws, size_t ws_size, hipStream_t stream) {
    static int grid = 0;
    if (grid == 0) {
        int dev = 0, cus = 0, per_cu = 0;
        hipGetDevice(&dev);
        hipDeviceGetAttribute(&cus, hipDeviceAttributeMultiprocessorCount, dev);
        hipFuncSetAttribute((const void*)fwd_kernel, hipFuncAttributeMaxDynamicSharedMemorySize, LDS_BYTES);
        hipOccupancyMaxActiveBlocksPerMultiprocessor(&per_cu, (const void*)fwd_kernel, NTHREADS, LDS_BYTES);
        if (per_cu < 1) { fprintf(stderr, "occupancy query says %d blocks/CU\n", per_cu); per_cu = 1; }
        grid = cus * 1;
        if (ws_size < WS_END) { fprintf(stderr, "workspace too small: %zu < %zu\n", ws_size, (size_t)WS_END); grid = -1; }
    }
    if (grid < 0) return;
    Params p{};
    for (int i = 0; i < 19; ++i) p.in[i] = (const float*)d_in[i];
    p.out = (float*)d_out; p.ws = (unsigned char*)d_ws;
#if MK_PER_PHASE_LAUNCH
    for (int ph = 0; ph < N_PHASES; ++ph) {
        p.ph_lo = ph; p.ph_hi = ph + 1;
        hipLaunchKernelGGL(fwd_kernel, dim3(grid), dim3(NTHREADS), LDS_BYTES, stream, p);
    }
#else
    p.ph_lo = 0; p.ph_hi = N_PHASES;
    hipMemsetAsync((char*)d_ws + WS_BAR, 0, 16384, stream);
    void* args[] = {&p};
    hipError_t e = hipLaunchCooperativeKernel((const void*)fwd_kernel, dim3(grid), dim3(NTHREADS), args, LDS_BYTES, stream);
    if (e != hipSuccess) fprintf(stderr, "cooperative launch failed: %s (grid %d)\n", hipGetErrorString(e), grid);
#endif
}
```
